# Optimizing an MI355X kernel written in HIP

```python
import jax, jax.numpy as jnp
from jax import lax
import numpy as np

D_MODEL = 1024
BATCH = 2
SEQ = 16384
DEPTH = 2

RMS_EPS = 1e-6
BLOCK = 128
DIL_PAIRS = ((128, 1), (512, 4), (2048, 16))
N_DIL_GROUPS = 3
DSA_HEADS = 8
DSA_HEAD_DIM = 64
DSA_WIDTH = DSA_HEADS * DSA_HEAD_DIM
DSA_QKV_COLS = N_DIL_GROUPS * 3 * DSA_WIDTH
MLA_HEADS = 16
QK_NOPE = 64
QK_ROPE = 32
V_DIM = 64
Q_LORA = 384
KV_LORA = 256
MLA_IN_COLS = Q_LORA + KV_LORA + QK_ROPE
ROPE_THETA = 10000.0
D_FF_DENSE = 2816
N_EXPERTS = 8
TOP_K = 2
D_FF_EXPERT = 3584

kernel_name = "hybrid_dilated_mla_moe_trunk"


def rmsnorm(x, g):
    xf = x.astype(jnp.float32)
    y = xf * lax.rsqrt(jnp.mean(xf * xf, axis=-1, keepdims=True) + RMS_EPS)
    return (y * g.astype(jnp.float32)).astype(x.dtype)


def alibi_slopes(n):
    return jnp.exp2(-8.0 * (jnp.arange(n, dtype=jnp.float32) + 1.0) / n)


def dilated_window_attention(q, k, v, pos, dilation, span, slopes):
    B, S, H, Dh = q.shape
    L = S // dilation
    nb = -(-L // BLOCK)
    Lp = nb * BLOCK

    def to_sub(a):
        a = jnp.swapaxes(a.reshape((B, L, dilation) + a.shape[2:]), 1, 2)
        return jnp.pad(a, [(0, 0), (0, 0), (0, Lp - L)] + [(0, 0)] * (a.ndim - 3))

    def band(a):
        a = jnp.pad(a, [(0, 0), (0, 0), (BLOCK, 0)] + [(0, 0)] * (a.ndim - 3))
        a = a.reshape((B, dilation, nb + 1, BLOCK) + a.shape[3:])
        return jnp.concatenate([a[:, :, :-1], a[:, :, 1:]], axis=3)

    qs, ks, vs, ps = to_sub(q), to_sub(k), to_sub(v), to_sub(pos)
    qb = qs.reshape(B, dilation, nb, BLOCK, H, Dh)
    kb, vb, pk = band(ks), band(vs), band(ps)
    pq = ps.reshape(B, dilation, nb, BLOCK)

    rel = jnp.arange(BLOCK)[:, None] + BLOCK - jnp.arange(2 * BLOCK)[None, :]
    key_idx = jnp.arange(nb)[:, None] * BLOCK + jnp.arange(2 * BLOCK)[None, :] - BLOCK
    valid = ((rel >= 0) & (rel <= span))[None] & (key_idx >= 0)[:, None, :]

    s = jnp.einsum('bgnqhd,bgnkhd->bgnhqk', qb, kb).astype(jnp.float32) * (Dh ** -0.5)
    dist = jnp.abs(pq[..., :, None] - pk[..., None, :]).astype(jnp.float32)
    s = s - slopes[:, None, None] * dist[:, :, :, None]
    s = jnp.where(valid[None, None, :, None], s, -jnp.inf)
    m = jnp.max(s, axis=-1, keepdims=True)
    p = jnp.exp(s - m)
    l = jnp.sum(p, axis=-1)
    o = jnp.einsum('bgnhqk,bgnkhd->bgnqhd', p, vb.astype(jnp.float32))
    o = o / jnp.swapaxes(l, -1, -2)[..., None]
    lse = jnp.swapaxes(m[..., 0] + jnp.log(l), -1, -2)

    def from_sub(a):
        a = a.reshape((B, dilation, Lp) + a.shape[4:])[:, :, :L]
        return jnp.swapaxes(a, 1, 2).reshape((B, S) + a.shape[3:])

    return from_sub(o), from_sub(lse)


def dilated_mixer(h, pos, w_qkv, w_out):
    B, S, _ = h.shape
    qkv = (h @ w_qkv).reshape(B, S, N_DIL_GROUPS, 3, DSA_HEADS, DSA_HEAD_DIM)
    slopes = alibi_slopes(DSA_HEADS)
    outs, lses = [], []
    for g, (window, dil) in enumerate(DIL_PAIRS):
        o, lse = dilated_window_attention(qkv[:, :, g, 0], qkv[:, :, g, 1], qkv[:, :, g, 2],
                                          pos, dil, window // dil, slopes)
        outs.append(o)
        lses.append(lse)
    wts = jax.nn.softmax(jnp.stack(lses), axis=0)
    mixed = jnp.sum(wts[..., None] * jnp.stack(outs), axis=0).astype(h.dtype)
    return mixed.reshape(B, S, DSA_WIDTH) @ w_out


def rope_tables(pos):
    inv = ROPE_THETA ** (-jnp.arange(0, QK_ROPE, 2, dtype=jnp.float32) / QK_ROPE)
    ang = pos.astype(jnp.float32)[..., None] * inv
    return jnp.cos(ang)[:, :, None, :], jnp.sin(ang)[:, :, None, :]


def apply_rope(x, cos, sin):
    xf = x.astype(jnp.float32)
    x1, x2 = xf[..., :QK_ROPE // 2], xf[..., QK_ROPE // 2:]
    return jnp.concatenate([x1 * cos - x2 * sin, x1 * sin + x2 * cos], axis=-1).astype(x.dtype)


def causal_block_attention(q, k, v, scale):
    B, S, H, Dq = q.shape
    Dv = v.shape[-1]
    nb = S // BLOCK
    qb = jnp.moveaxis(q.reshape(B, nb, BLOCK, H, Dq), 1, 0)
    kb = jnp.moveaxis(k.reshape(B, nb, BLOCK, H, Dq), 1, 0)
    vb = jnp.moveaxis(v.reshape(B, nb, BLOCK, H, Dv), 1, 0)
    ar = jnp.arange(BLOCK)

    def one_block(args):
        i, qi = args

        def body(j, carry):
            m, l, acc = carry
            kj = lax.dynamic_index_in_dim(kb, j, axis=0, keepdims=False)
            vj = lax.dynamic_index_in_dim(vb, j, axis=0, keepdims=False)
            s = jnp.einsum('bqhd,bkhd->bhqk', qi, kj).astype(jnp.float32) * scale
            mask = (j * BLOCK + ar)[None, :] <= (i * BLOCK + ar)[:, None]
            s = jnp.where(mask[None, None], s, -jnp.inf)
            m_new = jnp.maximum(m, jnp.max(s, axis=-1))
            corr = jnp.exp(m - m_new)
            p = jnp.exp(s - m_new[..., None])
            l = l * corr + jnp.sum(p, axis=-1)
            acc = acc * corr[..., None] + jnp.einsum('bhqk,bkhd->bhqd', p, vj.astype(jnp.float32))
            return m_new, l, acc

        init = (jnp.full((B, H, BLOCK), -jnp.inf, jnp.float32),
                jnp.zeros((B, H, BLOCK), jnp.float32),
                jnp.zeros((B, H, BLOCK, Dv), jnp.float32))
        _, l, acc = lax.fori_loop(0, i + 1, body, init)
        return jnp.swapaxes(acc / l[..., None], 1, 2)

    out = lax.map(one_block, (jnp.arange(nb), qb))
    return jnp.moveaxis(out, 0, 1).reshape(B, S, H, Dv).astype(q.dtype)


def mla_mixer(h, pos, w_in, q_norm_g, kv_norm_g, w_q_up, w_kv_up, w_out):
    B, S, _ = h.shape
    a = h @ w_in
    c_q = rmsnorm(a[..., :Q_LORA], q_norm_g)
    c_kv = rmsnorm(a[..., Q_LORA:Q_LORA + KV_LORA], kv_norm_g)
    k_rope = a[..., Q_LORA + KV_LORA:][:, :, None, :]
    q = (c_q @ w_q_up).reshape(B, S, MLA_HEADS, QK_NOPE + QK_ROPE)
    kv = (c_kv @ w_kv_up).reshape(B, S, MLA_HEADS, QK_NOPE + V_DIM)
    cos, sin = rope_tables(pos)
    q = jnp.concatenate([q[..., :QK_NOPE], apply_rope(q[..., QK_NOPE:], cos, sin)], axis=-1)
    k_rope = jnp.broadcast_to(apply_rope(k_rope, cos, sin), (B, S, MLA_HEADS, QK_ROPE))
    k = jnp.concatenate([kv[..., :QK_NOPE], k_rope], axis=-1)
    v = kv[..., QK_NOPE:]
    o = causal_block_attention(q, k, v, (QK_NOPE + QK_ROPE) ** -0.5)
    return o.reshape(B, S, MLA_HEADS * V_DIM) @ w_out


def swiglu(h, w_gate, w_up, w_down):
    return (jax.nn.silu(h @ w_gate) * (h @ w_up)) @ w_down


def moe_swiglu(h, w_router, w_gate, w_up, w_down):
    logits = (h @ w_router).astype(jnp.float32)
    top_logits, top_idx = lax.top_k(logits, TOP_K)
    top_w = jax.nn.softmax(top_logits, axis=-1)
    gates = jnp.sum(jax.nn.one_hot(top_idx, N_EXPERTS, dtype=jnp.float32) * top_w[..., None], axis=-2)
    y = jnp.zeros(h.shape, jnp.float32)
    for e in range(N_EXPERTS):
        y = y + gates[..., e:e + 1] * swiglu(h, w_gate[e], w_up[e], w_down[e]).astype(jnp.float32)
    return y.astype(h.dtype)


def setup_inputs(seed: int = 0) -> dict:
    key = jax.random.key(seed)
    ks = iter(jax.random.split(key, 32))
    na = (DEPTH + 1) // 2
    nb = DEPTH // 2

    def nrm(shape, fan_in):
        return jax.random.normal(next(ks), shape, jnp.float32) * (fan_in ** -0.5)

    def gain(shape):
        return 1.0 + 0.02 * jax.random.normal(next(ks), shape, jnp.float32)

    x = jax.random.normal(next(ks), (BATCH, SEQ, D_MODEL), jnp.float32)
    offsets = jax.random.randint(next(ks), (BATCH, 1), 0, 4096, dtype=jnp.int32)
    positions = offsets + jnp.arange(SEQ, dtype=jnp.int32)[None, :]
    return {
        "x": x,
        "positions": positions,
        "mix_norm_g": gain((DEPTH, D_MODEL)),
        "ffn_norm_g": gain((DEPTH, D_MODEL)),
        "a_w_qkv": nrm((na, D_MODEL, DSA_QKV_COLS), D_MODEL),
        "a_w_out": nrm((na, DSA_WIDTH, D_MODEL), DSA_WIDTH),
        "b_w_in": nrm((nb, D_MODEL, MLA_IN_COLS), D_MODEL),
        "b_q_norm_g": gain((nb, Q_LORA)),
        "b_kv_norm_g": gain((nb, KV_LORA)),
        "b_w_q_up": nrm((nb, Q_LORA, MLA_HEADS * (QK_NOPE + QK_ROPE)), Q_LORA),
        "b_w_kv_up": nrm((nb, KV_LORA, MLA_HEADS * (QK_NOPE + V_DIM)), KV_LORA),
        "b_w_out": nrm((nb, MLA_HEADS * V_DIM, D_MODEL), MLA_HEADS * V_DIM),
        "ffn_w_gate": nrm((na, D_MODEL, D_FF_DENSE), D_MODEL),
        "ffn_w_up": nrm((na, D_MODEL, D_FF_DENSE), D_MODEL),
        "ffn_w_down": nrm((na, D_FF_DENSE, D_MODEL), D_FF_DENSE),
        "moe_w_router": nrm((nb, D_MODEL, N_EXPERTS), D_MODEL),
        "moe_w_gate": nrm((nb, N_EXPERTS, D_MODEL, D_FF_EXPERT), D_MODEL),
        "moe_w_up": nrm((nb, N_EXPERTS, D_MODEL, D_FF_EXPERT), D_MODEL),
        "moe_w_down": nrm((nb, N_EXPERTS, D_FF_EXPERT, D_MODEL), D_FF_EXPERT),
        "final_norm_g": gain((D_MODEL,)),
    }


def reference(x, positions, mix_norm_g, ffn_norm_g, a_w_qkv, a_w_out, b_w_in, b_q_norm_g,
              b_kv_norm_g, b_w_q_up, b_w_kv_up, b_w_out, ffn_w_gate, ffn_w_up, ffn_w_down,
              moe_w_router, moe_w_gate, moe_w_up, moe_w_down, final_norm_g):
    for i in range(DEPTH):
        j = i // 2
        h = rmsnorm(x, mix_norm_g[i])
        if i % 2 == 0:
            x = x + dilated_mixer(h, positions, a_w_qkv[j], a_w_out[j])
        else:
            x = x + mla_mixer(h, positions, b_w_in[j], b_q_norm_g[j], b_kv_norm_g[j],
                              b_w_q_up[j], b_w_kv_up[j], b_w_out[j])
        h = rmsnorm(x, ffn_norm_g[i])
        if i % 2 == 0:
            x = x + swiglu(h, ffn_w_gate[j], ffn_w_up[j], ffn_w_down[j])
        else:
            x = x + moe_swiglu(h, moe_w_router[j], moe_w_gate[j], moe_w_up[j], moe_w_down[j])
    return rmsnorm(x, final_norm_g)
```

```cpp
#include <hip/hip_runtime.h>
#include <cstdio>
#include <cstdint>

#define LAS __attribute__((address_space(3)))
#define GAS __attribute__((address_space(1)))
typedef unsigned short bf16_t;
typedef short bf16x8 __attribute__((ext_vector_type(8)));
typedef short s16x4 __attribute__((ext_vector_type(4)));
typedef float f32x2 __attribute__((ext_vector_type(2)));
typedef float f32x4 __attribute__((ext_vector_type(4)));
typedef float f32x16 __attribute__((ext_vector_type(16)));
typedef unsigned u32x2 __attribute__((ext_vector_type(2)));
typedef unsigned u32x4 __attribute__((ext_vector_type(4)));
typedef __bf16 bf16x2_t __attribute__((ext_vector_type(2)));
typedef GAS unsigned gu32;

constexpr int BATCH = 2, SEQ = 16384, T = BATCH * SEQ, DM = 1024;
constexpr int QKVC = 4608;
constexpr int DSAW = 512;
constexpr int FF0 = 2816, FFE = 3584, NEXP = 8;
constexpr int MLA_IN = 672, MLA_INP = 768, QL = 384, KVL = 256, NH = 16, HQ = 96, QC = NH * HQ  , KVC = NH * 128  ;
constexpr float RMS_EPS = 1e-6f;
constexpr float LOG2E = 1.4426950408889634f;
constexpr float C2_DSA = 0.125f * LOG2E;
constexpr float C2_MLA = 0.10206207261596575f * LOG2E;
constexpr int MOE_MAXROWS = T + NEXP * 256;
constexpr int NWAVES = 8;
#ifndef MOE_TAIL_SPLIT
#define MOE_TAIL_SPLIT 2
#endif

constexpr size_t MiB = 1u << 20;
constexpr size_t WS_CTL = 0, CTL_ZERO_BYTES = 1 * MiB;
constexpr size_t WS_WQKV = 1 * MiB, WS_WOA = 10 * MiB, WS_WGU0 = 11 * MiB, WS_WD0 = 22 * MiB, WS_WIN = 28 * MiB, WS_WQUP = 30 * MiB, WS_WKVUP = 32 * MiB, WS_WOB = 33 * MiB;
constexpr size_t WS_COS = 35 * MiB, WS_SIN = 37 * MiB, WS_LSE = 39 * MiB, WS_KR = 42 * MiB;
constexpr size_t WS_SSL = 200 * MiB  ;
constexpr size_t WS_SSQ = 39 * MiB  , WS_RS = 46 * MiB  , WS_RSROW = 46 * MiB + 256 * 1024  , WS_XB1 = 292 * MiB  ;
constexpr size_t WS_E01 = 44 * MiB, WS_GWT = WS_E01 + 128 * 1024, WS_LIST = WS_GWT + 256 * 1024, WS_GWS = WS_LIST + 288 * 1024, WS_CNT = WS_GWS + 288 * 1024, WS_BASES = WS_CNT + 16 * 1024;
constexpr size_t WS_HN = 48 * MiB, WS_QKV = 112 * MiB, WS_O3 = 400 * MiB, WS_MIX = 48 * MiB, WS_ACT0 = 112 * MiB;
constexpr size_t WS_MOEGU = 360 * MiB  , WS_HN8 = 428 * MiB  , WS_MOED = 472 * MiB;
constexpr size_t WS_ALAT = 112 * MiB, WS_CQ = 160 * MiB, WS_CKV = 184 * MiB, WS_Q = 48 * MiB, WS_KV = 232 * MiB, WS_O = 144 * MiB, WS_ACTE = 112 * MiB;
constexpr size_t WS_END = 528 * MiB;
static_assert(WS_BASES + 4096 <= 46 * MiB, "routing tables");
static_assert(WS_ACTE + (size_t)MOE_MAXROWS * FFE * 2 <= WS_MOEGU, "moe act");
static_assert(2 * MOE_MAXROWS * 4 <= 288 * 1024, "list size");
constexpr int CW_BAR = 4096;

constexpr int RING_BYTES = 131072;
constexpr int MISC_OFF = 143360;
constexpr int LDS_BYTES = 147456;

#define RLX_AGENT __ATOMIC_RELAXED, __HIP_MEMORY_SCOPE_AGENT
#define LDS_WAIT() asm volatile("s_waitcnt lgkmcnt(0)" ::: "memory")
#define VM_WAIT() asm volatile("s_waitcnt vmcnt(0)" ::: "memory")
__device__ __forceinline__ unsigned f2bf(float f) { unsigned u = __builtin_bit_cast(unsigned, f); return (u + 0x7fffu + ((u >> 16) & 1u)) >> 16; }
__device__ __forceinline__ unsigned pk2(float lo, float hi) { f32x2 v = {lo, hi}; bf16x2_t b = __builtin_convertvector(v, bf16x2_t); return __builtin_bit_cast(unsigned, b); }
__device__ __forceinline__ unsigned pk4_fp8(float a, float b, float c, float d) { int p_ = __builtin_amdgcn_cvt_pk_fp8_f32(a, b, 0, false); p_ = __builtin_amdgcn_cvt_pk_fp8_f32(c, d, p_, true); return (unsigned)p_; }
__device__ __forceinline__ float bf2f(unsigned short h) { return __builtin_bit_cast(float, (unsigned)h << 16); }
__device__ __forceinline__ float bflo(unsigned w) { return __builtin_bit_cast(float, w << 16); }
__device__ __forceinline__ float bfhi(unsigned w) { return __builtin_bit_cast(float, w & 0xffff0000u); }
__device__ __forceinline__ float wave_sum(float v) {
    int x = __builtin_bit_cast(int, v);
    v += __builtin_bit_cast(float, __builtin_amdgcn_update_dpp(0, x, 0xB1, 0xF, 0xF, true));  x = __builtin_bit_cast(int, v);
    v += __builtin_bit_cast(float, __builtin_amdgcn_update_dpp(0, x, 0x4E, 0xF, 0xF, true));  x = __builtin_bit_cast(int, v);
    v += __builtin_bit_cast(float, __builtin_amdgcn_update_dpp(0, x, 0x141, 0xF, 0xF, true)); x = __builtin_bit_cast(int, v);
    v += __builtin_bit_cast(float, __builtin_amdgcn_update_dpp(0, x, 0x140, 0xF, 0xF, true)); x = __builtin_bit_cast(int, v);
    const float r0 = __builtin_bit_cast(float, __builtin_amdgcn_readlane(x, 0)), r1 = __builtin_bit_cast(float, __builtin_amdgcn_readlane(x, 16));
    const float r2 = __builtin_bit_cast(float, __builtin_amdgcn_readlane(x, 32)), r3 = __builtin_bit_cast(float, __builtin_amdgcn_readlane(x, 48));
    return (r0 + r1) + (r2 + r3);
}
__device__ __forceinline__ int lds_add(LAS int* p, int v) { return __hip_atomic_fetch_add(p, v, __ATOMIC_RELAXED, __HIP_MEMORY_SCOPE_WORKGROUP); }
__device__ __forceinline__ float fast_exp2(float x) { return __builtin_amdgcn_exp2f(x); }
__device__ __forceinline__ float fast_rcp(float x) { return __builtin_amdgcn_rcpf(x); }

#define XB_TMO      128
#define XB_XCNT(j)  (256  + 64 * (j))
#define XB_XSUB(j)  (1280 + 64 * (j))
#define XB_XGEN(j)  (2304 + 64 * (j))
#define XB_TOP      3328
#define XB_TOPGEN   3392
#define XCD_BAR_WORDS 3456
#define XB_SPIN_CAP (1u << 18)
__device__ __forceinline__ unsigned xb_ld(unsigned* p)              { return __hip_atomic_load(p, __ATOMIC_RELAXED, __HIP_MEMORY_SCOPE_AGENT); }
__device__ __forceinline__ unsigned xb_add(unsigned* p, unsigned v) { return __hip_atomic_fetch_add(p, v, __ATOMIC_RELAXED, __HIP_MEMORY_SCOPE_AGENT); }
__device__ __forceinline__ unsigned xb_xcc_id() { return (unsigned)__builtin_amdgcn_s_getreg((3 << 11) | 20) & 0xFu; }
#define XB_SPIN(cond, bar) do { unsigned _sp = 0; while (cond) { __builtin_amdgcn_s_sleep(1); \
    if ((++_sp & 255u) == 0u) { if (xb_ld(&(bar)[XB_TMO])) break; if (_sp > XB_SPIN_CAP) { atomicAdd(&(bar)[XB_TMO], 1u); break; } } } } while (0)
struct XcdBarrier { unsigned* bar; unsigned x; volatile LAS unsigned* st; };
__device__ __forceinline__ XcdBarrier xcd_barrier_post(unsigned* bar, volatile LAS unsigned* st) {
    XcdBarrier b; b.bar = bar; b.x = xb_xcc_id(); b.st = st;
    if (threadIdx.x == 0) (void)xb_add(&bar[XB_XCNT(b.x)], 1u);
    return b;
}
__device__ __forceinline__ void xcd_barrier_complete(unsigned* bar, unsigned x, unsigned& nloc, unsigned& nx) {
    const unsigned G = gridDim.x * gridDim.y * gridDim.z;
    unsigned sum, cnt, mine, sp = 0u;
    for (;;) {
        sum = 0u; cnt = 0u; mine = 0u;
#pragma unroll
        for (unsigned j = 0; j < 16; ++j) { const unsigned c = xb_ld(&bar[XB_XCNT(j)]); sum += c; cnt += (c > 0u) ? 1u : 0u; mine = (j == x) ? c : mine; }
        if (sum == G) break;
        __builtin_amdgcn_s_sleep(1);
        if ((++sp & 255u) == 0u) { if (xb_ld(&bar[XB_TMO])) break; if (sp > XB_SPIN_CAP) { atomicAdd(&bar[XB_TMO], 1u); break; } }
    }
    nloc = mine > 0u ? mine : 1u; nx = cnt > 0u ? cnt : 1u;
}
__device__ __forceinline__ void xcd_barrier(const XcdBarrier& b) {
    asm volatile("s_waitcnt vmcnt(0)" ::: "memory");
    __syncthreads();
    if (threadIdx.x == 0) {
        unsigned* bar = b.bar;
        __builtin_amdgcn_s_waitcnt(0);
        unsigned nloc = b.st[0], nx = b.st[1];
        if (nloc == 0u) { xcd_barrier_complete(bar, b.x, nloc, nx); b.st[0] = nloc; b.st[1] = nx; }
        const unsigned old = xb_add(&bar[XB_XSUB(b.x)], 1u);
        const unsigned gen = old / nloc;
        if (old + 1u == (gen + 1u) * nloc) {
            __builtin_amdgcn_fence(__ATOMIC_RELEASE, "agent");
            asm volatile("s_waitcnt vmcnt(0)" ::: "memory");
            const unsigned og = xb_add(&bar[XB_TOP], 1u);
            const unsigned tg = og / nx;
            if (og + 1u == (tg + 1u) * nx) xb_add(&bar[XB_TOPGEN], 1u);
            else XB_SPIN(xb_ld(&bar[XB_TOPGEN]) == tg, bar);
            __builtin_amdgcn_fence(__ATOMIC_ACQUIRE, "agent");
            xb_add(&bar[XB_XGEN(b.x)], 1u);
            asm volatile("s_waitcnt vmcnt(0)" ::: "memory");
        } else {
            XB_SPIN(xb_ld(&bar[XB_XGEN(b.x)]) == gen, bar);
            __builtin_amdgcn_fence(__ATOMIC_ACQUIRE, "agent");
            asm volatile("s_waitcnt vmcnt(0)" ::: "memory");
        }
    }
    __syncthreads();
}

namespace pg {
constexpr int BM = 256, BK = 64, HALF = 128, HTB = HALF * BK * 2, STAGE_BYTES = 8 * HTB, NXCD = 8, WGM = 8;
__host__ __device__ __forceinline__ int lds_byte(int r, int c) { const int st = (r >> 4) * 2 + (c >> 5), rr = r & 15, cc = c & 31, ob = rr * 64 + cc * 2; return st * 1024 + (ob ^ (((ob >> 9) & 1) << 5)); }
__host__ __device__ __forceinline__ void stage_rc(int b, int& R, int& C) { const int st = b / 1024, sb = b % 1024, swz = sb ^ (((sb >> 9) & 1) << 5); R = (st >> 1) * 16 + swz / 64; C = (st & 1) * 32 + (swz % 64) / 2; }
__host__ __device__ __forceinline__ int perm32(int rho) { const int n = rho >> 4, i = rho & 15; return 8 * (i >> 2) + 4 * n + (i & 3); }

struct Unit { int pm, pn; long boff; int koff; };

struct StaticOrder {
    int nM, nN, nwg, G, c;
    __device__ __forceinline__ void init(int M, int N, int G_, int c_) { nM = M / BM; nN = N / BM; nwg = nM * nN; G = G_; c = c_; }
    __device__ __forceinline__ bool next(int i, Unit& u) const {
        const long L = (long)i * G + c; if (L >= nwg) return false;
        int wgid = (int)L; { const int q = nwg / NXCD, r = nwg % NXCD, xcd = wgid % NXCD, off = wgid / NXCD; wgid = (xcd < r ? xcd * (q + 1) : r * (q + 1) + (xcd - r) * q) + off; }
        const int nig = WGM * nN, gid = wgid / nig, fm = gid * WGM, gsz = (nM - fm) < WGM ? (nM - fm) : WGM;
        u.pm = fm + ((wgid % nig) % gsz); u.pn = (wgid % nig) / gsz; u.boff = 0; u.koff = 0; return true;
    }
};
template <int NN, int KSPLIT, long ESTRIDE>
struct MoeOrder {
    static constexpr int nN = NN, ksplit = KSPLIT; static constexpr long estride = ESTRIDE;
    int t0, t1, G, c, klen; int base[NEXP + 1];
    int rd_ntc = 0, rd_R = 1 << 20;
    __device__ __forceinline__ bool next(int i, Unit& u) const {
        const int late = i - rd_R > 0 ? i - rd_R : 0;
        const int L = i * G + c - late * rd_ntc, nwg = (t1 - t0) * nN * ksplit;
        if (L >= nwg || (late > 0 && c < rd_ntc)) return false;
        int ks, pm_, pn_;
        if (ksplit == 1) {
            int wgid = (int)L; { const int q = nwg / NXCD, r = nwg % NXCD, xcd = wgid % NXCD, off = wgid / NXCD; wgid = (xcd < r ? xcd * (q + 1) : r * (q + 1) + (xcd - r) * q) + off; }
            const int nT_ = t1 - t0, nig = WGM * nN, gid = wgid / nig, fm = gid * WGM, gsz = (nT_ - fm) < WGM ? (nT_ - fm) : WGM;
            pm_ = fm + ((wgid % nig) % gsz); pn_ = (wgid % nig) / gsz; ks = 0;
        } else { ks = (int)(L % ksplit); const int r = (int)(L / ksplit); pm_ = r / nN; pn_ = r % nN; }
        u.pm = t0 + pm_; u.pn = pn_; u.koff = ks * klen;
        int e = 0;
#pragma unroll
        for (int k = 1; k < NEXP; ++k) if (u.pm * BM >= base[k]) e = k;
        u.boff = (long)e * estride; return true;
    }
};

typedef f32x4 Acc[2][2][4][2];
typedef float f32x32 __attribute__((ext_vector_type(32)));
typedef f32x32 Acc32[2][2];
__device__ __forceinline__ f32x4 acc4(const Acc& a, int ai, int bj, int m, int n) { return a[ai][bj][m][n]; }
__device__ __forceinline__ f32x4 acc4(const Acc32& a, int ai, int bj, int m, int n) { const int e = (m * 2 + n) * 4; return (f32x4){a[ai][bj][e], a[ai][bj][e + 1], a[ai][bj][e + 2], a[ai][bj][e + 3]}; }

struct EpiQKV {
    static constexpr bool PERM = true;
    bf16_t* O; float scale_q;
    __device__ __forceinline__ void operator()(const Acc& acc, const Unit& u, int wr, int wc, int fr, int fq) const {
        const int gp = u.pn >> 1, g = gp / 3, dsh = 2 * g, hb = (u.pn & 1) * 4;
        const float sc = (gp - 3 * g) == 0 ? scale_q : 1.f;
        const int row0 = u.pm * BM + wr * 64 + fr, d0 = (wc & 1) * 32 + 8 * fq;
#pragma unroll
        for (int ai = 0; ai < 2; ++ai)
#pragma unroll
            for (int m = 0; m < 4; ++m) { const int r = row0 + ai * HALF + m * 16, t = r & (SEQ - 1);
                const size_t rp = (size_t)(r - t) + ((size_t)(t & ((1 << dsh) - 1)) << (14 - dsh)) + (t >> dsh);
#pragma unroll
                for (int bj = 0; bj < 2; ++bj) { const f32x4 v0 = acc[ai][bj][m][0] * sc, v1 = acc[ai][bj][m][1] * sc;
                    u32x4 w; w.x = pk2(v0[0], v0[1]); w.y = pk2(v0[2], v0[3]); w.z = pk2(v1[0], v1[1]); w.w = pk2(v1[2], v1[3]);
                    *(u32x4*)(O + ((size_t)(gp * 8 + hb + 2 * bj + (wc >> 1)) * T + rp) * 64 + d0) = w; } }
    }
};
static_assert(SEQ == (1 << 14), "residue-major row arithmetic assumes SEQ = 2^14");
__device__ __forceinline__ float quad_col_sum(float s) {
    s += __builtin_bit_cast(float, __builtin_amdgcn_ds_swizzle(__builtin_bit_cast(int, s), 0x401F));
    return s + __builtin_bit_cast(float, __builtin_amdgcn_ds_bpermute((int)((threadIdx.x ^ 32u) << 2), __builtin_bit_cast(int, s)));
}
template <bool F32RES, bool F32OUT>
struct EpiResBf {
    static constexpr bool PERM = true;
    const void* res; float* out; bf16_t* xb; float* ssq;
    __device__ __forceinline__ void operator()(const Acc& acc, const Unit& u, int wr, int wc, int fr, int fq) const {
        const int col0 = u.pn * BM + wc * 32 + 8 * fq;
#pragma unroll
        for (int ai = 0; ai < 2; ++ai)
#pragma unroll
            for (int m = 0; m < 4; ++m) { const int row = u.pm * BM + ai * HALF + wr * 64 + m * 16 + fr; const size_t off = (size_t)row * DM + col0; float sq = 0.f;
#pragma unroll
                for (int bj = 0; bj < 2; ++bj) {
                    f32x4 v0, v1;
                    if (F32RES) { v0 = *(const f32x4*)((const float*)res + off + bj * HALF); v1 = *(const f32x4*)((const float*)res + off + bj * HALF + 4); }
                    else { const u32x4 rw = *(const u32x4*)((const bf16_t*)res + off + bj * HALF); v0 = (f32x4){bflo(rw.x), bfhi(rw.x), bflo(rw.y), bfhi(rw.y)}; v1 = (f32x4){bflo(rw.z), bfhi(rw.z), bflo(rw.w), bfhi(rw.w)}; }
                    v0 = v0 + acc[ai][bj][m][0]; v1 = v1 + acc[ai][bj][m][1];
                    if (F32OUT) { *(f32x4*)(out + off + bj * HALF) = v0; *(f32x4*)(out + off + bj * HALF + 4) = v1; }
                    sq += (v0[0] * v0[0] + v0[1] * v0[1]) + (v0[2] * v0[2] + v0[3] * v0[3]) + (v1[0] * v1[0] + v1[1] * v1[1]) + (v1[2] * v1[2] + v1[3] * v1[3]);
                    u32x4 w; w.x = pk2(v0[0], v0[1]); w.y = pk2(v0[2], v0[3]); w.z = pk2(v1[0], v1[1]); w.w = pk2(v1[2], v1[3]);
                    *(u32x4*)(xb + off + bj * HALF) = w; }
                sq = quad_col_sum(sq);
                if (fq == 0) ssq[(size_t)row * 16 + 4 * u.pn + wc] = sq; }
    }
};
__device__ __forceinline__ float row_rrms(const float* ssq, int row) {
    const f32x4* p = (const f32x4*)(ssq + (size_t)row * 16); const f32x4 a = p[0], b = p[1], c = p[2], d = p[3];
    const float t = (((a[0] + a[1]) + (a[2] + a[3])) + ((b[0] + b[1]) + (b[2] + b[3]))) + (((c[0] + c[1]) + (c[2] + c[3])) + ((d[0] + d[1]) + (d[2] + d[3])));
    return __builtin_amdgcn_rsqf(t * (1.f / DM) + RMS_EPS);
}
template <int Q0, int NQ>
__device__ __forceinline__ float slot_rrms(const float* ssl, int row, float inv_n) {
    const f32x4* p = (const f32x4*)(ssl + (size_t)row * 32) + Q0; float t = 0.f;
#pragma unroll
    for (int q = 0; q < NQ; ++q) { const f32x4 a = p[q]; t += (a[0] + a[1]) + (a[2] + a[3]); }
    return __builtin_amdgcn_rsqf(t * inv_n + RMS_EPS);
}
struct EpiLat {
    static constexpr bool PERM = true;
    bf16_t* cq; bf16_t* ckv; bf16_t* kr; const float* ssq; float* ssl; const float* cs; const float* sn;
    __device__ __forceinline__ void operator()(const Acc& acc, const Unit& u, int wr, int wc, int fr, int fq) const {
        const int row0 = u.pm * BM + wr * 64 + fr;
#pragma unroll
        for (int ai = 0; ai < 2; ++ai)
#pragma unroll
            for (int m = 0; m < 4; ++m) { const int row = row0 + ai * HALF + m * 16; const float sc = row_rrms(ssq, row);
#pragma unroll
                for (int bj = 0; bj < 2; ++bj) { const int cb = u.pn * BM + bj * HALF;
                    const f32x4 v0 = acc[ai][bj][m][0] * sc, v1 = acc[ai][bj][m][1] * sc;
                    if (cb < QL + KVL) {
                        u32x4 w; w.x = pk2(v0[0], v0[1]); w.y = pk2(v0[2], v0[3]); w.z = pk2(v1[0], v1[1]); w.w = pk2(v1[2], v1[3]);
                        bf16_t* dst = cb < QL ? cq + (size_t)row * QL + cb : ckv + (size_t)row * KVL + (cb - QL);
                        *(u32x4*)(dst + wc * 32 + 8 * fq) = w;
                        float sq = (v0[0] * v0[0] + v0[1] * v0[1]) + (v0[2] * v0[2] + v0[3] * v0[3]) + (v1[0] * v1[0] + v1[1] * v1[1]) + (v1[2] * v1[2] + v1[3] * v1[3]);
                        sq = quad_col_sum(sq);
                        if (fq == 0) ssl[(size_t)row * 32 + (cb >> 7) * 4 + wc] = sq;
                    } else if (cb == QL + KVL && wc == 0) {
                        const f32x4 c = *(const f32x4*)(cs + (size_t)row * 16 + 4 * fq), s_ = *(const f32x4*)(sn + (size_t)row * 16 + 4 * fq);
                        u32x4 w; w.x = pk2(v0[0] * c[0] - v0[1] * s_[0], v0[0] * s_[0] + v0[1] * c[0]); w.y = pk2(v0[2] * c[1] - v0[3] * s_[1], v0[2] * s_[1] + v0[3] * c[1]);
                        w.z = pk2(v1[0] * c[2] - v1[1] * s_[2], v1[0] * s_[2] + v1[1] * c[2]); w.w = pk2(v1[2] * c[3] - v1[3] * s_[3], v1[2] * s_[3] + v1[3] * c[3]);
                        *(u32x4*)(kr + (size_t)row * 32 + 8 * fq) = w; } } }
    }
};
struct EpiKVScale {
    static constexpr bool PERM = true;
    bf16_t* O; int ldc; const float* ssl;
    __device__ __forceinline__ void operator()(const Acc& acc, const Unit& u, int wr, int wc, int fr, int fq) const {
        const int row0 = u.pm * BM + wr * 64 + fr, col0 = u.pn * BM + wc * 32 + 8 * fq;
#pragma unroll
        for (int ai = 0; ai < 2; ++ai)
#pragma unroll
            for (int m = 0; m < 4; ++m) { const int row = row0 + ai * HALF + m * 16; const float sc = slot_rrms<3, 2>(ssl, row, 1.f / KVL); bf16_t* rowp = O + (size_t)row * ldc + col0;
#pragma unroll
                for (int bj = 0; bj < 2; ++bj) { const f32x4 v0 = acc[ai][bj][m][0] * sc, v1 = acc[ai][bj][m][1] * sc;
                    u32x4 w; w.x = pk2(v0[0], v0[1]); w.y = pk2(v0[2], v0[3]); w.z = pk2(v1[0], v1[1]); w.w = pk2(v1[2], v1[3]);
                    *(u32x4*)(rowp + bj * HALF) = w; } }
    }
};
template <int RS, bool OUT8 = false>
struct EpiSwiGLUT {
    static constexpr bool PERM = true;
    bf16_t* O; int ldc; const float* rs;
    template <class AccT>
    __device__ __forceinline__ void operator()(const AccT& acc, const Unit& u, int wr, int wc, int fr, int fq) const {
        const int row0 = u.pm * BM + wr * 64 + fr, col0 = u.pn * HALF + wc * 32 + 8 * fq;
        float rrv[8];
#pragma unroll
        for (int i = 0; i < 8; ++i) rrv[i] = RS ? rs[row0 + (i >> 2) * HALF + (i & 3) * 16] : 1.f;
        if (RS) __builtin_amdgcn_sched_barrier(0);
#pragma unroll
        for (int ai = 0; ai < 2; ++ai)
#pragma unroll
            for (int m = 0; m < 4; ++m) { float o[8]; const float rr = rrv[ai * 4 + m];
                const float c1 = -rr * LOG2E, kk = fast_rcp(rr * rr * (OUT8 ? 8.f : 1.f));
#pragma unroll
                for (int n = 0; n < 2; ++n) { const f32x4 ag = acc4(acc, ai, 0, m, n), au = acc4(acc, ai, 1, m, n);
#pragma unroll
                    for (int j = 0; j < 4; ++j) o[4 * n + j] = (ag[j] * au[j]) * fast_rcp(__builtin_fmaf(fast_exp2(ag[j] * c1), kk, kk)); }
                if (OUT8) { u32x2 w8; w8.x = pk4_fp8(o[0], o[1], o[2], o[3]); w8.y = pk4_fp8(o[4], o[5], o[6], o[7]);
                    *(u32x2*)((unsigned char*)O + (size_t)(row0 + ai * HALF + m * 16) * ldc + col0) = w8; }
                else { u32x4 w; w.x = pk2(o[0], o[1]); w.y = pk2(o[2], o[3]); w.z = pk2(o[4], o[5]); w.w = pk2(o[6], o[7]);
                    *(u32x4*)(O + (size_t)(row0 + ai * HALF + m * 16) * ldc + col0) = w; } }
    }
};
typedef EpiSwiGLUT<1, true> EpiSwiGLU;
struct EpiQRope {
    static constexpr bool PERM = true;
    bf16_t* O; const float* cs; const float* sn; const float* ssl;
    __device__ __forceinline__ void operator()(const Acc& acc, const Unit& u, int wr, int wc, int fr, int fq) const {
        const int row0 = u.pm * BM + wr * 64 + fr;
#pragma unroll
        for (int ai = 0; ai < 2; ++ai)
#pragma unroll
            for (int m = 0; m < 4; ++m) { const int row = row0 + ai * HALF + m * 16; const float qs = C2_MLA * slot_rrms<0, 3>(ssl, row, 1.f / QL);
#pragma unroll
                for (int bj = 0; bj < 2; ++bj) { const int c0 = u.pn * BM + bj * HALF + wc * 32 + 8 * fq; const int cc = c0 % HQ;
                    f32x4 v0 = acc[ai][bj][m][0], v1 = acc[ai][bj][m][1];
                    if (cc >= 64) { const int i0 = (cc - 64) >> 1;
                        const f32x4 c = *(const f32x4*)(cs + (size_t)row * 16 + i0), s = *(const f32x4*)(sn + (size_t)row * 16 + i0);
                        const f32x4 a = v0, b = v1;
                        v0[0] = a[0] * c[0] - a[1] * s[0]; v0[1] = a[0] * s[0] + a[1] * c[0]; v0[2] = a[2] * c[1] - a[3] * s[1]; v0[3] = a[2] * s[1] + a[3] * c[1];
                        v1[0] = b[0] * c[2] - b[1] * s[2]; v1[1] = b[0] * s[2] + b[1] * c[2]; v1[2] = b[2] * c[3] - b[3] * s[3]; v1[3] = b[2] * s[3] + b[3] * c[3]; }
                    v0 = v0 * qs; v1 = v1 * qs;
                    u32x4 w; w.x = pk2(v0[0], v0[1]); w.y = pk2(v0[2], v0[3]); w.z = pk2(v1[0], v1[1]); w.w = pk2(v1[2], v1[3]);
                    *(u32x4*)(O + (size_t)row * QC + c0) = w; } }
    }
};
struct EpiMoeDown {
    static constexpr bool PERM = false;
    float* out; const int* list; const float* gws; const bf16_t* xb;
    template <class AccT>
    __device__ __forceinline__ void operator()(const AccT& acc, const Unit& u, int wr, int wc, int fr, int fq) const {
        const int col0 = u.pn * BM + wc * 32 + 4 * fq;
#pragma unroll
        for (int ai = 0; ai < 2; ++ai)
#pragma unroll
            for (int m = 0; m < 4; ++m) { const int r = u.pm * BM + ai * HALF + wr * 64 + m * 16 + fr; const int tok = list[r]; const float w = gws[r];
                if (tok >= 0) { float* p = out + (size_t)tok * DM + col0;
#pragma unroll
                    for (int bj = 0; bj < 2; ++bj)
#pragma unroll
                        for (int n = 0; n < 2; ++n) { f32x4 b;
                            if (xb) { const u32x2 bw = *(const u32x2*)(xb + (size_t)tok * DM + col0 + bj * HALF + n * 16); b = (f32x4){bflo(bw.x), bfhi(bw.x), bflo(bw.y), bfhi(bw.y)}; }
                            else b = *(const f32x4*)(p + bj * HALF + n * 16);
                            *(f32x4*)(p + bj * HALF + n * 16) = b + acc4(acc, ai, bj, m, n) * w; } } }
    }
};

struct EpiMoeDownAtomic {
    static constexpr bool PERM = false;
    float* out; const int* list; const float* gws;
    template <class AccT>
    __device__ __forceinline__ void operator()(const AccT& acc, const Unit& u, int wr, int wc, int fr, int fq) const {
        const int col0 = u.pn * BM + wc * 32 + 4 * fq;
#pragma unroll
        for (int ai = 0; ai < 2; ++ai)
#pragma unroll
            for (int m = 0; m < 4; ++m) { const int r = u.pm * BM + ai * HALF + wr * 64 + m * 16 + fr; const int tok = list[r]; const float w = gws[r];
                if (tok >= 0) { float* p = out + (size_t)tok * DM + col0;
#pragma unroll
                    for (int bj = 0; bj < 2; ++bj)
#pragma unroll
                        for (int n = 0; n < 2; ++n) { const f32x4 av = acc4(acc, ai, bj, m, n);
#pragma unroll
                            for (int j = 0; j < 4; ++j) (void)__hip_atomic_fetch_add(p + bj * HALF + n * 16 + j, av[j] * w, __ATOMIC_RELAXED, __HIP_MEMORY_SCOPE_AGENT); } } }
    }
};

typedef int v8i32_t __attribute__((ext_vector_type(8)));
typedef int v4i32_t __attribute__((ext_vector_type(4)));
template <bool C, class A_, class B_> struct Sel { typedef A_ type; };
template <class A_, class B_> struct Sel<false, A_, B_> { typedef B_ type; };
template <class Epi, class Sched, bool GATHER, bool FP8 = false, int SCALE_A = 127, int SCALE_B = 127>
__device__ __forceinline__ void gemm_phase(LAS unsigned char* lds, const bf16_t* A, const bf16_t* Bt, const int Kc, const int ldc_, const int* list, const Sched& S, const Epi& E) {
    int K = Kc; asm volatile("" : "+s"(K));
    int LD = ldc_; asm volatile("" : "+s"(LD));
    int tid = threadIdx.x; asm volatile("" : "+v"(tid));
    const int wid = __builtin_amdgcn_readfirstlane(tid >> 6), lane = tid & 63, wr = wid >> 2, wc = wid & 3, fr = lane & 15, fq = lane >> 4;
    const int nt = K / BK;
    unsigned voffA[2], voffB[2];
#pragma unroll
    for (int i = 0; i < 2; ++i) { int R, C; stage_rc(tid * 16 + i * 8192, R, C); const int Rb = Epi::PERM ? ((R & ~31) + perm32(R & 31)) : R; voffA[i] = (unsigned)(R * LD + C) * 2u; voffB[i] = (unsigned)(Rb * LD + C) * 2u; }
    const size_t kstep = (size_t)(BK * 2);
    const size_t hstep = (size_t)HALF * LD * 2;
    const size_t tstep = 2 * hstep;
    const unsigned ldsw = (unsigned)wid * 1024u;
    const int aoff = lds_byte(wr * 64 + fr, fq * 8), boff = lds_byte(wc * 32 + fr, fq * 8);
    const char* A8 = (const char*)A;
#define PG_SA(b, h) (((b) * 2 + (h)) * HTB)
#define PG_SB(b, h) ((4 + (b) * 2 + (h)) * HTB)
#define PG_GLDS(src, bufoff, i_) __builtin_amdgcn_global_load_lds((const unsigned*)(src), (LAS unsigned*)(lds + (bufoff) + ldsw + (i_) * 8192), 16, 0, 0)
#define PG_STAGE_B(bufoff, gbase) do { _Pragma("unroll") for (int _i = 0; _i < 2; ++_i) PG_GLDS((const char*)(gbase) + voffB[_i], bufoff, _i); } while (0)
#define PG_STAGE_A(bufoff, CUR, h, kb) do { _Pragma("unroll") for (int _i = 0; _i < 2; ++_i) { \
        if constexpr (GATHER) PG_GLDS(((CUR) ? cA : nA) + (kb) + ((CUR) ? vaC[h][_i] : vaN[h][_i]), bufoff, _i); \
        else PG_GLDS(((CUR) ? cA : nA) + (size_t)(h) * hstep + (kb) + voffA[_i], bufoff, _i); } } while (0)
#define PG_LD1(D_, ADDR_) do { if constexpr (FP8) { const v4i32_t lo_ = *(const LAS v4i32_t*)(ADDR_), hi_ = *(const LAS v4i32_t*)((ADDR_) + 1024); D_ = __builtin_shufflevector(lo_, hi_, 0, 1, 2, 3, 4, 5, 6, 7); } \
        else { D_[0] = *(const LAS bf16x8*)(ADDR_); D_[1] = *(const LAS bf16x8*)((ADDR_) + 1024); } } while (0)
#define PG_LDA(dst, b, h) do { _Pragma("unroll") for (int m = 0; m < 4; ++m) PG_LD1(dst[m], lds + PG_SA(b, h) + aoff + m * 2048); } while (0)
#define PG_LDB(dst, b, h) do { _Pragma("unroll") for (int n = 0; n < 2; ++n) PG_LD1(dst[n], lds + PG_SB(b, h) + boff + n * 2048); } while (0)
#define PG_MMA(ai, bj, At, Bq) do { __builtin_amdgcn_s_setprio(1); _Pragma("unroll") for (int m = 0; m < 4; ++m) _Pragma("unroll") for (int n = 0; n < 2; ++n) { \
        if constexpr (FP8) { f32x4 c_; _Pragma("unroll") for (int j_ = 0; j_ < 4; ++j_) c_[j_] = acc[ai][bj][(m * 2 + n) * 4 + j_]; \
            asm volatile("v_mfma_f32_16x16x128_f8f6f4 %0, %1, %2, %0" : "+v"(c_) : "v"(Bq[n]), "v"(At[m])); \
            _Pragma("unroll") for (int j_ = 0; j_ < 4; ++j_) acc[ai][bj][(m * 2 + n) * 4 + j_] = c_[j_]; } \
        else { _Pragma("unroll") for (int k = 0; k < 2; ++k) acc[ai][bj][m][n] = __builtin_amdgcn_mfma_f32_16x16x32_bf16(Bq[n][k], At[m][k], acc[ai][bj][m][n], 0, 0, 0); } } \
        __builtin_amdgcn_s_setprio(0); } while (0)
#define PG_WAIT_V(n) asm volatile("s_waitcnt vmcnt(" #n ")" ::: "memory")
#define PG_WAIT_L(n) asm volatile("s_waitcnt lgkmcnt(" #n ")" ::: "memory")
#define PG_BAR __builtin_amdgcn_s_barrier()
#define PG_SCHED __builtin_amdgcn_sched_barrier(0)
#define PG_LOAD_VA(dst, U) do { _Pragma("unroll") for (int _h = 0; _h < 2; ++_h) _Pragma("unroll") for (int _i = 0; _i < 2; ++_i) { int _R, _C; stage_rc(tid * 16 + _i * 8192, _R, _C); \
        int _r = list[(U).pm * BM + _h * HALF + _R]; _r = _r < 0 ? 0 : _r; dst[_h][_i] = (unsigned)_r * (unsigned)(LD * 2) + (unsigned)(_C * 2); } } while (0)
    Unit cur, nxt; int ui = 0;
    if (!S.next(0, cur)) return;
    typename Sel<FP8, Acc32, Acc>::type acc;
#define PG_ZERO_ACC() do { _Pragma("unroll") for (int a = 0; a < 2; ++a) _Pragma("unroll") for (int b = 0; b < 2; ++b) { \
        if constexpr (FP8) { _Pragma("unroll") for (int e_ = 0; e_ < 32; ++e_) acc[a][b][e_] = 0.f; } \
        else { _Pragma("unroll") for (int m = 0; m < 4; ++m) _Pragma("unroll") for (int n = 0; n < 2; ++n) acc[a][b][m][n] = (f32x4){0.f, 0.f, 0.f, 0.f}; } } } while (0)
    PG_ZERO_ACC();
    typename Sel<FP8, v8i32_t[4], bf16x8[4][2]>::type At; typename Sel<FP8, v8i32_t[2], bf16x8[2][2]>::type B0, B1;
    unsigned vaC[2][2], vaN[2][2];
    if constexpr (GATHER) { PG_LOAD_VA(vaC, cur); }
    const char* cA = A8 + (GATHER ? 0 : (size_t)cur.pm * tstep) + (size_t)cur.koff * 2; const char* nA = cA;
    const char* cB = (const char*)(Bt + cur.boff + cur.koff) + (size_t)cur.pn * tstep;
    PG_STAGE_B(PG_SB(0, 0), cB); PG_STAGE_B(PG_SB(0, 1), cB + hstep); PG_STAGE_A(PG_SA(0, 0), true, 0, 0); PG_STAGE_A(PG_SA(0, 1), true, 1, 0);
    if (wr == 1) PG_BAR;
    PG_WAIT_V(2); PG_BAR;
    PG_STAGE_B(PG_SB(1, 0), cB + kstep); PG_STAGE_A(PG_SA(1, 0), true, 0, kstep); PG_STAGE_B(PG_SB(1, 1), cB + hstep + kstep);
    PG_WAIT_V(6); PG_BAR;
    for (;;) {
        const bool has_next = S.next(ui + 1, nxt);
        const char* nB = has_next ? (const char*)(Bt + nxt.boff + nxt.koff) + (size_t)nxt.pn * tstep : cB;
        nA = has_next ? A8 + (GATHER ? 0 : (size_t)nxt.pm * tstep) + (size_t)nxt.koff * 2 : cA;
        if constexpr (GATHER) {
            if (has_next) { PG_LOAD_VA(vaN, nxt); }
            else {
#pragma unroll
                for (int h = 0; h < 2; ++h)
#pragma unroll
                    for (int i = 0; i < 2; ++i) vaN[h][i] = vaC[h][i]; }
        }
        for (int t = 0; t < nt; t += 2) {
            const bool last = (t == nt - 2);
            const size_t a1k = (size_t)(t + 1) * kstep;
            const size_t a2k = last ? 0 : (size_t)(t + 2) * kstep; const size_t a3k = a2k + kstep;
            const char* b2 = last ? nB : cB + (size_t)(t + 2) * kstep; const char* b3 = b2 + kstep;
            PG_LDB(B0, 0, 0); PG_LDB(B1, 0, 1); PG_SCHED; PG_LDA(At, 0, 0); PG_STAGE_A(PG_SA(1, 1), true, 1, a1k);
            PG_WAIT_V(8); PG_WAIT_L(0); PG_BAR; PG_MMA(0, 0, At, B0); PG_MMA(0, 1, At, B1); PG_BAR; PG_SCHED;
            PG_LDA(At, 0, 1); PG_STAGE_B(PG_SB(0, 0), b2); PG_STAGE_B(PG_SB(0, 1), b2 + hstep); PG_STAGE_A(PG_SA(0, 0), !last, 0, a2k);
            PG_WAIT_V(8); PG_WAIT_L(0); PG_BAR; PG_MMA(1, 0, At, B0); PG_MMA(1, 1, At, B1); PG_BAR; PG_SCHED;
            PG_LDB(B0, 1, 0); PG_LDB(B1, 1, 1); PG_SCHED; PG_LDA(At, 1, 0); PG_STAGE_A(PG_SA(0, 1), !last, 1, a2k);
            PG_WAIT_V(8); PG_WAIT_L(0); PG_BAR; PG_MMA(0, 0, At, B0); PG_MMA(0, 1, At, B1); PG_BAR; PG_SCHED;
            PG_LDA(At, 1, 1); PG_STAGE_B(PG_SB(1, 0), b3); PG_STAGE_B(PG_SB(1, 1), b3 + hstep); PG_STAGE_A(PG_SA(1, 0), !last, 0, a3k);
            PG_WAIT_V(8); PG_WAIT_L(0); PG_BAR; PG_MMA(1, 0, At, B0); PG_MMA(1, 1, At, B1); PG_BAR; PG_SCHED;
        }
        if (wr == 0) PG_BAR;
        if constexpr (FP8) asm volatile("s_nop 15\n\ts_nop 15" ::: "memory");
        E(acc, cur, wr, wc, fr, fq);
        if (!has_next) break;
        PG_ZERO_ACC();
        cur = nxt; cB = nB; cA = nA; ++ui;
        if constexpr (GATHER) {
#pragma unroll
            for (int h = 0; h < 2; ++h)
#pragma unroll
                for (int i = 0; i < 2; ++i) vaC[h][i] = vaN[h][i]; }
        if (wr == 1) PG_BAR;
    }
    PG_WAIT_V(0);
    PG_BAR;
#undef PG_SA
#undef PG_SB
#undef PG_GLDS
#undef PG_STAGE_A
#undef PG_STAGE_B
#undef PG_LD1
#undef PG_ZERO_ACC
#undef PG_LDA
#undef PG_LDB
#undef PG_MMA
#undef PG_WAIT_V
#undef PG_WAIT_L
#undef PG_BAR
#undef PG_SCHED
#undef PG_LOAD_VA
}
}

namespace att {
typedef short v4i16_t __attribute__((ext_vector_type(4)));
__device__ __forceinline__ int crow(int r, int hi) { return (r & 3) + 8 * (r >> 2) + 4 * hi; }
#define ATT_WAIT_BAR(N) asm volatile("s_waitcnt vmcnt(" #N ") lgkmcnt(0)\n\ts_barrier" ::: "memory")
__device__ __forceinline__ void glds16(const void* gsrc, unsigned lds_dst) { unsigned keep;
    asm volatile("s_mov_b32 %0, m0\n\ts_mov_b32 m0, %2\n\ts_nop 0\n\tglobal_load_lds_dwordx4 %1, off\n\ts_mov_b32 m0, %0" : "=&s"(keep) : "v"(gsrc), "s"(lds_dst) : "memory"); }
__device__ __forceinline__ unsigned lds_addr(const LAS unsigned char* p) { return (unsigned)(uintptr_t)p; }
template <int NKS>
__device__ __forceinline__ void qkt(f32x16& p0, f32x16& p1, const LAS unsigned char* Kslot, const bf16x8 (&qr)[NKS], int r32, int hi) {
    const LAS unsigned char* kb = Kslot + hi * 1024 + r32 * 16;
    f32x16 z;
#pragma unroll
    for (int r = 0; r < 16; ++r) z[r] = 0.f;
    p0 = z; p1 = z;
#pragma unroll
    for (int d0 = 0; d0 < NKS; ++d0) {
        const bf16x8 b0 = *(const LAS bf16x8*)(kb + d0 * 2048);
        const bf16x8 b1 = *(const LAS bf16x8*)(kb + d0 * 2048 + 512);
        p0 = __builtin_amdgcn_mfma_f32_32x32x16_bf16(b0, qr[d0], p0, 0, 0, 0);
        p1 = __builtin_amdgcn_mfma_f32_32x32x16_bf16(b1, qr[d0], p1, 0, 0, 0);
    }
}
__device__ __forceinline__ void softmax_step(f32x16& p0, f32x16& p1, float& m_run, float& l_run, f32x16 (&o)[2], LAS float* wsf, int r32, int hi) {
    float rm = fmaxf(p0[0], p1[0]);
#pragma unroll
    for (int r = 1; r < 16; ++r) rm = fmaxf(rm, fmaxf(p0[r], p1[r]));
    { auto rr = __builtin_amdgcn_permlane32_swap(__float_as_uint(rm), __float_as_uint(rm), false, false); rm = fmaxf(__uint_as_float(rr[0]), __uint_as_float(rr[1])); }
    const float m_new = fmaxf(m_run, rm);
    const float alpha = fast_exp2(m_run - m_new);
    float s = 0.f;
#pragma unroll
    for (int r = 0; r < 16; ++r) { p0[r] = fast_exp2(p0[r] - m_new); p1[r] = fast_exp2(p1[r] - m_new); s += p0[r] + p1[r]; }
    l_run = l_run * alpha + s;
    const bool need = __any(m_new > m_run);
    m_run = m_new;
    if (need) {
        if (hi == 0) wsf[r32] = alpha;
        LDS_WAIT();
#pragma unroll
        for (int r = 0; r < 16; ++r) { const float f = wsf[crow(r, hi)]; o[0][r] *= f; o[1][r] *= f; }
        LDS_WAIT();
    }
}
__device__ __forceinline__ void pv_step(f32x16 (&o)[2], const f32x16& p0, const f32x16& p1, const LAS unsigned char* Vslot, int lane, int hi) {
    u32x4 pw[4];
    pw[0] = (u32x4){pk2(p0[0], p0[1]), pk2(p0[2], p0[3]), pk2(p0[4], p0[5]), pk2(p0[6], p0[7])};
    pw[1] = (u32x4){pk2(p0[8], p0[9]), pk2(p0[10], p0[11]), pk2(p0[12], p0[13]), pk2(p0[14], p0[15])};
    pw[2] = (u32x4){pk2(p1[0], p1[1]), pk2(p1[2], p1[3]), pk2(p1[4], p1[5]), pk2(p1[6], p1[7])};
    pw[3] = (u32x4){pk2(p1[8], p1[9]), pk2(p1[10], p1[11]), pk2(p1[12], p1[13]), pk2(p1[14], p1[15])};
    const LAS unsigned char* vb = Vslot + ((lane >> 4) & 1) * 32 + (lane & 3) * 8 + (4 * hi + ((lane & 15) >> 2)) * 64;
#pragma unroll
    for (int d0 = 0; d0 < 2; ++d0)
#pragma unroll
        for (int ks = 0; ks < 4; ++ks) {
            const s16x4 lo = __builtin_bit_cast(s16x4, __builtin_amdgcn_ds_read_tr16_b64_v4i16((LAS v4i16_t*)(vb + d0 * 4096 + ks * 1024)));
            const s16x4 hh = __builtin_bit_cast(s16x4, __builtin_amdgcn_ds_read_tr16_b64_v4i16((LAS v4i16_t*)(vb + d0 * 4096 + ks * 1024 + 512)));
            const bf16x8 vf = (bf16x8){lo[0], lo[1], lo[2], lo[3], hh[0], hh[1], hh[2], hh[3]};
            o[d0] = __builtin_amdgcn_mfma_f32_32x32x16_bf16(__builtin_bit_cast(bf16x8, pw[ks]), vf, o[d0], 0, 0, 0);
        }
}
__device__ __forceinline__ float finish_rows(f32x16 (&o)[2], float l_run, LAS float* wsf, LAS bf16_t* stg, int r32, int hi) {
    const float l = l_run + __shfl_xor(l_run, 32);
    if (hi == 0) wsf[32 + r32] = l;
    LDS_WAIT();
#pragma unroll
    for (int r = 0; r < 16; ++r) { const int orow = crow(r, hi); const float rl = fast_rcp(wsf[32 + orow]);
#pragma unroll
        for (int d0 = 0; d0 < 2; ++d0) stg[orow * 64 + d0 * 32 + r32] = (bf16_t)f2bf(o[d0][r] * rl); }
    LDS_WAIT();
    return l;
}
}

struct Args { const void* in[20]; float* out; unsigned char* ws; };

struct Frame {
    LAS unsigned char* lds;
    int tid, lane, wave, G, bid;
};
__device__ __forceinline__ Frame phase_frame(const Frame& F) { Frame P = F; asm volatile("" : "+v"(P.tid)); P.lane = P.tid & 63; return P; }

__device__ __forceinline__ void tr_item(const float* __restrict__ W, int ldw, int k0, int scol, bf16_t* WT, int K, int drow0, LAS float* scr, int lane, const float* gain = nullptr) {
#pragma unroll 8
    for (int i = 0; i < 32; ++i) { const int kk = 2 * i + (lane >> 5); scr[kk * 33 + (lane & 31)] = scol >= 0 ? W[(size_t)(k0 + kk) * ldw + scol] * (gain ? gain[k0 + kk] : 1.f) : 0.f; }
    LDS_WAIT(); asm volatile("" ::: "memory");
    const int c = lane & 7;
#pragma unroll
    for (int j = 0; j < 4; ++j) { const int n = (lane >> 3) + 8 * j; const LAS float* s = scr + (8 * c) * 33 + n;
        u32x4 o; o.x = pk2(s[0 * 33], s[1 * 33]); o.y = pk2(s[2 * 33], s[3 * 33]); o.z = pk2(s[4 * 33], s[5 * 33]); o.w = pk2(s[6 * 33], s[7 * 33]);
        *(u32x4*)(WT + (size_t)(drow0 + n) * K + k0 + 8 * c) = o; }
    LDS_WAIT(); asm volatile("" ::: "memory");
}
template <bool GAIN = false, bool FP8 = false>
__device__ __forceinline__ void tr_item64(const float* __restrict__ W, int ldw, int k0, int scol0, bf16_t* WT, int K, int drow0, LAS unsigned char* scr, int lane, const float* gain = nullptr) {
    const int kr = lane >> 4, nq = lane & 15;
    const float* src = W + (size_t)(k0 + kr) * ldw + scol0 + 4 * nq;
    f32x4 v[16];
#pragma unroll
    for (int i = 0; i < 16; ++i) v[i] = __builtin_nontemporal_load((const f32x4*)(src + (size_t)(4 * i) * ldw));
    if (GAIN) {
#pragma unroll
        for (int i = 0; i < 16; ++i) v[i] = v[i] * gain[k0 + kr + 4 * i]; }
#pragma unroll
    for (int i = 0; i < 16; ++i) { u32x2 w; w.x = pk2(v[i].x, v[i].y); w.y = pk2(v[i].z, v[i].w); *(LAS u32x2*)(scr + (4 * i + kr) * 192 + nq * 8) = w; }
    LDS_WAIT(); asm volatile("" ::: "memory");
    const int g = lane >> 4;
    const LAS unsigned char* rb = scr + ((lane & 15) >> 2) * 192 + g * 32 + (lane & 3) * 8;
    bf16_t* dst = WT + (size_t)(drow0 + 16 * g + (lane & 15)) * K + k0;
    unsigned char* dst8 = (unsigned char*)WT + (size_t)(drow0 + 16 * g + (lane & 15)) * K + k0;
#pragma unroll
    for (int kc = 0; kc < 8; ++kc) {
        const s16x4 lo = __builtin_bit_cast(s16x4, __builtin_amdgcn_ds_read_tr16_b64_v4i16((LAS att::v4i16_t*)(rb + (8 * kc) * 192)));
        const s16x4 hh = __builtin_bit_cast(s16x4, __builtin_amdgcn_ds_read_tr16_b64_v4i16((LAS att::v4i16_t*)(rb + (8 * kc + 4) * 192)));
        if (FP8) { u32x2 w8;
            w8.x = pk4_fp8(bf2f((unsigned short)lo[0]) * 64.f, bf2f((unsigned short)lo[1]) * 64.f, bf2f((unsigned short)lo[2]) * 64.f, bf2f((unsigned short)lo[3]) * 64.f);
            w8.y = pk4_fp8(bf2f((unsigned short)hh[0]) * 64.f, bf2f((unsigned short)hh[1]) * 64.f, bf2f((unsigned short)hh[2]) * 64.f, bf2f((unsigned short)hh[3]) * 64.f);
            *(u32x2*)(dst8 + 8 * kc) = w8;
        } else *(bf16x8*)(dst + 8 * kc) = (bf16x8){lo[0], lo[1], lo[2], lo[3], hh[0], hh[1], hh[2], hh[3]};
    }
    LDS_WAIT(); asm volatile("" ::: "memory");
}
template <bool GAIN = false, bool FP8 = false>
__device__ __forceinline__ void tr_plain64(const float* W, int K, int N, bf16_t* WT, LAS unsigned char* scr, int item, int lane, const float* gain = nullptr) {
    const int nblk = N / 64, kb = item / nblk, nb = item % nblk;
    tr_item64<GAIN, FP8>(W, N, 64 * kb, 64 * nb, WT, K, 64 * nb, scr, lane, gain);
}
template <bool GAIN = false, bool FP8 = false>
__device__ __forceinline__ void tr_gateup64(const float* Wg, const float* Wu, int K, int F, bf16_t* WT, LAS unsigned char* scr, int item, int lane, const float* gain = nullptr) {
    const int nblk = (2 * F) / 64, kb = item / nblk, nb = item % nblk, n0 = 64 * nb, p = n0 >> 8, x = n0 & 255;
    tr_item64<GAIN, FP8>(x < 128 ? Wg : Wu, F, 64 * kb, 128 * p + (x & 127), WT, K, n0, scr, lane, gain);
}

__device__ __forceinline__ void load_gain(const float* g, f32x4 (&gv)[4], int lane) {
#pragma unroll
    for (int j = 0; j < 4; ++j) gv[j] = ((const f32x4*)g)[64 * j + lane];
}
__device__ __forceinline__ void norm_pass(const Frame& F, const float* x, const float* g, bf16_t* hn) {
    f32x4 gv[4]; load_gain(g, gv, F.lane);
    const int gw = F.bid * NWAVES + F.wave, NGW = F.G * NWAVES;
    f32x4 v[4], vn[4];
    if (gw < T) { const f32x4* xr = (const f32x4*)(x + (size_t)gw * DM) + F.lane;
#pragma unroll
        for (int j = 0; j < 4; ++j) v[j] = xr[64 * j]; }
    for (int m = gw; m < T; m += NGW) {
        const int mn = m + NGW < T ? m + NGW : m;
        { const f32x4* xr = (const f32x4*)(x + (size_t)mn * DM) + F.lane;
#pragma unroll
          for (int j = 0; j < 4; ++j) vn[j] = xr[64 * j]; }
        __builtin_amdgcn_sched_barrier(0);
        float s = 0.f;
#pragma unroll
        for (int j = 0; j < 4; ++j) s += (v[j].x * v[j].x + v[j].y * v[j].y) + (v[j].z * v[j].z + v[j].w * v[j].w);
        const float r = __builtin_amdgcn_rsqf(wave_sum(s) * (1.f / DM) + RMS_EPS);
        u32x2* o8 = (u32x2*)(hn + (size_t)m * DM) + F.lane;
#pragma unroll
        for (int j = 0; j < 4; ++j) { const f32x4 y = v[j] * r * gv[j]; u32x2 w; w.x = pk2(y.x, y.y); w.y = pk2(y.z, y.w); o8[64 * j] = w; }
#pragma unroll
        for (int j = 0; j < 4; ++j) v[j] = vn[j];
    }
}

__device__ __forceinline__ float max3f(float a, float b, float c) { float r; asm("v_max3_f32 %0, %1, %2, %3" : "=v"(r) : "v"(a), "v"(b), "v"(c)); return r; }
constexpr int DA_K = 0, DA_V = 49152, DA_POS = 98304, DA_WS = DA_POS + 2048, DA_OST = DA_WS + 2048, DA_END = DA_OST + 32768;
static_assert(DA_END <= MISC_OFF, "dilated attention LDS");
struct DilUnit { int h, g, dil, res, q0; size_t rowb, srow; };
__device__ __forceinline__ DilUnit dil_decode(int u) {
    DilUnit d; d.h = u & 7; int rest = u >> 3; const int blk64 = rest & 63; rest >>= 6; d.g = rest % 3; const int b = rest / 3;
    const int dsh = 2 * d.g; d.dil = 1 << dsh;
    const int bpr = 64 >> dsh;
    d.res = blk64 / bpr; d.q0 = (blk64 % bpr) * 256;
    d.rowb = (size_t)b * SEQ; d.srow = d.rowb + (size_t)d.res * (SEQ >> dsh); return d;
}
__device__ __forceinline__ void dilated_phase(const Frame& F, const bf16_t* qkv, const int* positions, bf16_t* o3, float* lse) {
    const int lane = F.lane, wid = F.wave, r32 = lane & 31, hi = lane >> 5, tid = F.tid;
    LAS unsigned char* lds = F.lds;
    LAS float* posf = (LAS float*)(lds + DA_POS);
    LAS float* wsf = (LAS float*)(lds + DA_WS) + wid * 64;
    LAS bf16_t* stg = (LAS bf16_t*)(lds + DA_OST) + wid * 2048;
    const unsigned ldsb = att::lds_addr(lds);
    constexpr int NUNITS = BATCH * 3 * 64 * 8;
    int u = F.bid;
    if (u >= NUNITS) return;
    DilUnit d = dil_decode(u);
#define DA_SLAB(D_, part_) (qkv + ((size_t)(((D_).g * 3 + (part_)) * 8 + (D_).h) * T + (D_).srow) * 64)
#define DA_DMA_K(D_) do { const bf16_t* kb_ = DA_SLAB(D_, 1) + wid * 8; _Pragma("unroll") for (int j_ = 0; j_ < 6; ++j_) { int kl_ = (D_).q0 - 128 + 64 * j_ + lane; kl_ = kl_ < 0 ? 0 : kl_; \
        att::glds16(kb_ + (size_t)kl_ * 64, (unsigned)__builtin_amdgcn_readfirstlane(ldsb + DA_K + j_ * 8192 + wid * 1024)); } } while (0)
#define DA_DMA_V(D_) do { const bf16_t* vb_ = DA_SLAB(D_, 2) + (wid >> 2) * 32 + (lane & 3) * 8; _Pragma("unroll") for (int j_ = 0; j_ < 6; ++j_) { int vl_ = (D_).q0 - 128 + 64 * j_ + 16 * (wid & 3) + (lane >> 2); vl_ = vl_ < 0 ? 0 : vl_; \
        att::glds16(vb_ + (size_t)vl_ * 64, (unsigned)__builtin_amdgcn_readfirstlane(ldsb + DA_V + j_ * 8192 + wid * 1024)); } } while (0)
#define DA_QLOAD(Q_, PQ_, D_) do { const int ql_ = (D_).q0 + 32 * wid + r32; const bf16_t* qp_ = DA_SLAB(D_, 0) + (size_t)ql_ * 64 + hi * 8; \
        _Pragma("unroll") for (int d0_ = 0; d0_ < 4; ++d0_) Q_[d0_] = *(const bf16x8*)(qp_ + d0_ * 16); PQ_ = positions[(D_).rowb + (size_t)ql_ * (D_).dil + (D_).res]; } while (0)
#define DA_POSLOAD(P_, D_) do { int kl_ = (D_).q0 - 128 + (tid < 384 ? tid : 128); kl_ = kl_ < 0 ? 0 : kl_; P_ = positions[(D_).rowb + (size_t)kl_ * (D_).dil + (D_).res]; } while (0)
    bf16x8 qr[4]; int posqi = 0, posn = 0;
    DA_POSLOAD(posn, d);
    posf[tid] = (float)posn;
    DA_DMA_K(d);
    DA_QLOAD(qr, posqi, d);
#define DA_TOP(N) do { ATT_WAIT_BAR(N); _Pragma("unroll") for (int d0_ = 0; d0_ < 4; ++d0_) asm volatile("" : "+v"(qr[d0_])); asm volatile("" : "+v"(posqi)); } while (0)
    DA_TOP(0);
#pragma unroll 1
    for (;;) {
        DA_DMA_V(d);
        const int un = u + F.G; const bool has_next = un < NUNITS;
        const DilUnit dn = dil_decode(has_next ? un : u);
        if (has_next) DA_POSLOAD(posn, dn);
        __builtin_amdgcn_sched_barrier(0);
        const float posq = (float)posqi;
        const float slope2 = __builtin_amdgcn_exp2f(-(float)(d.h + 1)) * LOG2E;
        const int j0 = wid >> 1;
        f32x16 p0[3], p1[3];
#pragma unroll
        for (int jj = 0; jj < 3; ++jj) {
            const int j = j0 + jj;
            att::qkt<4>(p0[jj], p1[jj], lds + DA_K + j * 8192, qr, r32, hi);
            const int relb = 128 + 32 * wid + r32 - 64 * j, klb = d.q0 - 128 + 64 * j;
            const int lo = max(relb - 128, -klb);
            const unsigned spanp1 = (unsigned)max(relb - lo + 1, 0);
            const int ub = 4 * hi - lo;
            const LAS f32x4* pk4 = (const LAS f32x4*)(posf + 64 * j + 4 * hi);
#pragma unroll
            for (int gq = 0; gq < 4; ++gq) {
                const f32x4 k0v = pk4[2 * gq], k1v = pk4[2 * gq + 8];
#pragma unroll
                for (int c = 0; c < 4; ++c) { const int r = 4 * gq + c;
                    { const bool ok = (unsigned)(ub + 8 * gq + c) < spanp1; const float dd = posq - k0v[c]; const float v = __builtin_fmaf(-slope2, __builtin_fabsf(dd), p0[jj][r]); p0[jj][r] = ok ? v : -INFINITY; }
                    { const bool ok = (unsigned)(ub + 8 * gq + c + 32) < spanp1; const float dd = posq - k1v[c]; const float v = __builtin_fmaf(-slope2, __builtin_fabsf(dd), p1[jj][r]); p1[jj][r] = ok ? v : -INFINITY; } }
            }
        }
        float m;
        { float a = max3f(p0[0][0], p0[0][1], p1[0][0]), bq = max3f(p0[0][2], p0[0][3], p1[0][1]); a = max3f(a, p1[0][2], p1[0][3]);
#pragma unroll
          for (int jj = 0; jj < 3; ++jj)
#pragma unroll
              for (int r = (jj == 0 ? 4 : 0); r < 16; r += 4) { a = max3f(a, p0[jj][r], p0[jj][r + 1]); bq = max3f(bq, p0[jj][r + 2], p0[jj][r + 3]); a = max3f(a, p1[jj][r], p1[jj][r + 1]); bq = max3f(bq, p1[jj][r + 2], p1[jj][r + 3]); }
          float rm = fmaxf(a, bq); { auto rr = __builtin_amdgcn_permlane32_swap(__float_as_uint(rm), __float_as_uint(rm), false, false); rm = fmaxf(__uint_as_float(rr[0]), __uint_as_float(rr[1])); }
          m = rm; }
        float l_run = 0.f;
#pragma unroll
        for (int jj = 0; jj < 3; ++jj) { float s0 = 0.f, s1 = 0.f;
#pragma unroll
            for (int r = 0; r < 16; ++r) { p0[jj][r] = fast_exp2(p0[jj][r] - m); p1[jj][r] = fast_exp2(p1[jj][r] - m); s0 += p0[jj][r]; s1 += p1[jj][r]; }
            l_run += s0 + s1; }
        ATT_WAIT_BAR(0);
        bf16x8 qn[4]; int posqn = 0;
        if (has_next) {
            posf[tid] = (float)posn;
            DA_DMA_K(dn);
            DA_QLOAD(qn, posqn, dn);
        } else {
#pragma unroll
            for (int d0 = 0; d0 < 4; ++d0) qn[d0] = qr[d0];
        }
        __builtin_amdgcn_sched_barrier(0);
        f32x16 o[2];
#pragma unroll
        for (int r = 0; r < 16; ++r) { o[0][r] = 0.f; o[1][r] = 0.f; }
#pragma unroll
        for (int jj = 0; jj < 3; ++jj) att::pv_step(o, p0[jj], p1[jj], lds + DA_V + (j0 + jj) * 8192, lane, hi);
        const float l = att::finish_rows(o, l_run, wsf, stg, r32, hi);
        const size_t qrow = d.rowb + (size_t)(d.q0 + 32 * wid + r32) * d.dil + d.res;
        if (hi == 0) lse[((size_t)d.g * T + qrow) * 8 + d.h] = m + __builtin_amdgcn_logf(l);
        bf16_t* obase = o3 + (size_t)d.g * T * DSAW + d.h * 64;
#pragma unroll
        for (int i = 0; i < 4; ++i) { const int row = i * 8 + (lane >> 3), ch = lane & 7; const u32x4 v = *(const LAS u32x4*)(stg + row * 64 + ch * 8);
            const size_t orow = d.rowb + (size_t)(d.q0 + 32 * wid + row) * d.dil + d.res;
            *(u32x4*)(obase + orow * DSAW + ch * 8) = v; }
        if (!has_next) break;
        u = un; d = dn; posqi = posqn;
#pragma unroll
        for (int d0 = 0; d0 < 4; ++d0) qr[d0] = qn[d0];
        DA_TOP(4);
    }
    ATT_WAIT_BAR(0);
#undef DA_TOP
#undef DA_SLAB
#undef DA_DMA_K
#undef DA_DMA_V
#undef DA_QLOAD
#undef DA_POSLOAD
}
__device__ __forceinline__ void merge_pass(const Frame& F, const bf16_t* o3, const float* lse, bf16_t* mix) {
    const int gw = F.bid * NWAVES + F.wave, NGW = F.G * NWAVES, lane = F.lane, h = lane >> 3;
    float l[3], ln[3]; u32x4 a[3], an[3];
#define MG_LOAD(L_, A_, m_) do { _Pragma("unroll") for (int g_ = 0; g_ < 3; ++g_) { L_[g_] = lse[((size_t)g_ * T + (m_)) * 8 + h]; A_[g_] = *(const u32x4*)(o3 + ((size_t)g_ * T + (m_)) * DSAW + lane * 8); } } while (0)
    if (gw < T) MG_LOAD(l, a, gw);
    for (int m = gw; m < T; m += NGW) {
        const int mn = m + NGW < T ? m + NGW : m;
        MG_LOAD(ln, an, mn);
        __builtin_amdgcn_sched_barrier(0);
        const float mx = fmaxf(l[0], fmaxf(l[1], l[2]));
        float l0 = fast_exp2(l[0] - mx), l1 = fast_exp2(l[1] - mx), l2 = fast_exp2(l[2] - mx);
        const float inv = fast_rcp(l0 + l1 + l2); l0 *= inv; l1 *= inv; l2 *= inv;
        u32x4 w;
#pragma unroll
        for (int k = 0; k < 4; ++k) w[k] = pk2(l0 * bflo(a[0][k]) + l1 * bflo(a[1][k]) + l2 * bflo(a[2][k]), l0 * bfhi(a[0][k]) + l1 * bfhi(a[1][k]) + l2 * bfhi(a[2][k]));
        *(u32x4*)(mix + (size_t)m * DSAW + lane * 8) = w;
#pragma unroll
        for (int g = 0; g < 3; ++g) { l[g] = ln[g]; a[g] = an[g]; }
    }
#undef MG_LOAD
}

__device__ __forceinline__ void mla_pv(f32x16 (&o)[2], const u32x4 (&pw)[4], const LAS unsigned char* Vslot, int lane, int hi) {
    const LAS unsigned char* vb = Vslot + ((lane >> 4) & 1) * 32 + (lane & 3) * 8 + (4 * hi + ((lane & 15) >> 2)) * 64;
#pragma unroll
    for (int ks = 0; ks < 4; ++ks)
#pragma unroll
        for (int d0 = 0; d0 < 2; ++d0) {
            const s16x4 lo = __builtin_bit_cast(s16x4, __builtin_amdgcn_ds_read_tr16_b64_v4i16((LAS att::v4i16_t*)(vb + d0 * 4096 + ks * 1024)));
            const s16x4 hh = __builtin_bit_cast(s16x4, __builtin_amdgcn_ds_read_tr16_b64_v4i16((LAS att::v4i16_t*)(vb + d0 * 4096 + ks * 1024 + 512)));
            const bf16x8 vf = (bf16x8){lo[0], lo[1], lo[2], lo[3], hh[0], hh[1], hh[2], hh[3]};
            o[d0] = __builtin_amdgcn_mfma_f32_32x32x16_bf16(__builtin_bit_cast(bf16x8, pw[ks]), vf, o[d0], 0, 0, 0);
        }
}
constexpr int H4_K = 0, H4_KS = 12288, H4_V = 4 * H4_KS, H4_VS = 8192, H4_WS = H4_V + 3 * H4_VS, H4_OST = H4_WS + 2048, H4_END = H4_OST + 32768;
static_assert(H4_END <= MISC_OFF, "mla attention (hand-interleaved) LDS");
__device__ __forceinline__ void mla_attn_phase4(const Frame& F, const bf16_t* Q, const bf16_t* KV, const bf16_t* KR, bf16_t* O) {
    const int lane = F.lane, wid = F.wave, r32 = lane & 31, hi = lane >> 5;
    LAS unsigned char* lds = F.lds;
    LAS float* wsf = (LAS float*)(lds + H4_WS) + wid * 64;
    LAS bf16_t* stg = (LAS bf16_t*)(lds + H4_OST) + wid * 2048;
    const unsigned ldsb = att::lds_addr(lds);
    volatile LAS unsigned* redo_flag = (volatile LAS unsigned*)(lds + MISC_OFF) + 24;
    const int vcu = (F.G % 8 == 0) ? (F.bid % 8) * (F.G / 8) + F.bid / 8 : F.bid;
    constexpr int NQB = SEQ / 256;
    constexpr int NUNITS = BATCH * NH * NQB;
    const int nper = (NUNITS + F.G - 1) / F.G;
    const LAS unsigned char* kp0 = lds + H4_K + hi * 1024 + r32 * 16;
    const LAS unsigned char* vp0 = lds + H4_V + ((lane >> 4) & 1) * 32 + (lane & 3) * 8 + (4 * hi + ((lane & 15) >> 2)) * 64;
#define H4_SB() __builtin_amdgcn_sched_barrier(0)
#define H4_PIN(x) asm volatile("" : "+v"(x))
#define H4_WAIT_BAR(N) asm volatile("s_waitcnt vmcnt(" #N ") lgkmcnt(0)\n\ts_barrier" ::: "memory")
#define H4_WAIT3() do { if (wid < 4) { H4_WAIT_BAR(3); } else { H4_WAIT_BAR(2); } } while (0)
#define H4_VTR(p) __builtin_bit_cast(s16x4, __builtin_amdgcn_ds_read_tr16_b64_v4i16((LAS att::v4i16_t*)(p)))
#define H4_MFMA(a, b, c) __builtin_amdgcn_mfma_f32_32x32x16_bf16(a, b, c, 0, 0, 0)
#define H4_Z (f32x16){0.f, 0.f, 0.f, 0.f, 0.f, 0.f, 0.f, 0.f, 0.f, 0.f, 0.f, 0.f, 0.f, 0.f, 0.f, 0.f}
    for (int i = 0; i < nper; ++i) {
        int bh, qb;
        if (F.G == 256) { const int s = vcu & 7; bh = vcu >> 3; const int k2 = i >> 1; qb = (i & 1) ? (16 * k2 + 15 - s) : (16 * k2 + s); }
        else { const int it = i * F.G + F.bid; if (it >= NUNITS) break; bh = it / NQB; qb = NQB - 1 - (it % NQB); }
        bool safe = false;
        for (;;) {
        const int b = bh / NH, h = bh % NH;
        const size_t rowb = (size_t)b * SEQ; const int q0 = qb * 256;
        const int NT = 4 * (qb + 1);
        int ln_ = threadIdx.x & 63; asm volatile("" : "+v"(ln_));
        const bf16_t* ksrc = KV + (rowb + ln_) * KVC + h * 128 + wid * 8;
        const bf16_t* rsrc = KR + (rowb + ln_) * 32 + (wid & 3) * 8;
        const bf16_t* vsrc = KV + (rowb + 16 * (wid & 3) + (ln_ >> 2)) * KVC + h * 128 + 64 + (wid >> 2) * 32 + (ln_ & 3) * 8;
#define H4_DMA_K(t, slot) do { \
        att::glds16(ksrc + (size_t)(t) * 64 * KVC, (unsigned)__builtin_amdgcn_readfirstlane(ldsb + H4_K + (slot) * H4_KS + wid * 1024)); \
        if (wid < 4) att::glds16(rsrc + (size_t)(t) * 64 * 32, (unsigned)__builtin_amdgcn_readfirstlane(ldsb + H4_K + (slot) * H4_KS + (8 + wid) * 1024)); } while (0)
#define H4_DMA_V(t, slot) att::glds16(vsrc + (size_t)(t) * 64 * KVC, (unsigned)__builtin_amdgcn_readfirstlane(ldsb + H4_V + (slot) * H4_VS + wid * 1024))
        H4_DMA_K(0, 0); H4_DMA_V(0, 0); H4_DMA_K(1, 1);
        bf16x8 qr[6];
        { const bf16_t* qp = Q + (rowb + q0 + 32 * wid + (ln_ & 31)) * QC + h * HQ + (ln_ >> 5) * 8;
#pragma unroll
          for (int d0 = 0; d0 < 6; ++d0) qr[d0] = *(const bf16x8*)(qp + d0 * 16); }
        float mhat = 0.f, l_reg = 0.f; f32x16 o[2], pA0, pA1, pB0, pB1, negm; bool resc = false;
#pragma unroll
        for (int r = 0; r < 16; ++r) { o[0][r] = 0.f; o[1][r] = 0.f; negm[r] = 0.f; }
        H4_PIN(negm);
        const int qrel = 32 * wid + r32;
        int sp = 0, sc = 0, sn = 1, kc = 0;
#define H4_ROT() do { sp = sc; sc = sn; sn = (sn == 2) ? 0 : sn + 1; kc = (kc + 1) & 3; } while (0)
#define H4_CMASK(P0, P1, t) do { const int jb_ = (t) - (NT - 4); if (jb_ >= 0) { _Pragma("unroll") for (int r = 0; r < 16; ++r) { const int kv_ = 64 * jb_ + att::crow(r, hi); if (kv_ > qrel) P0[r] = -INFINITY; if (kv_ + 32 > qrel) P1[r] = -INFINITY; } } } while (0)
#define H4_RESC() do { if (resc) { LDS_WAIT(); _Pragma("unroll") for (int d_ = 0; d_ < 2; ++d_) _Pragma("unroll") for (int r = 0; r < 16; ++r) o[d_][r] *= wsf[att::crow(r, hi)]; } } while (0)
        H4_DMA_K(2, 2);
#pragma unroll
        for (int d0 = 0; d0 < 6; ++d0) H4_PIN(qr[d0]);
        if (wid < 4) { H4_WAIT_BAR(5); } else { H4_WAIT_BAR(3); }
        { const LAS unsigned char* kb = kp0;
#pragma unroll
          for (int d0 = 0; d0 < 6; ++d0) { const bf16x8 b0 = *(const LAS bf16x8*)(kb + d0 * 2048), b1 = *(const LAS bf16x8*)(kb + d0 * 2048 + 512);
              if (d0 == 0) { pA0 = H4_MFMA(b0, qr[0], H4_Z); pA1 = H4_MFMA(b1, qr[0], H4_Z); } else { pA0 = H4_MFMA(b0, qr[d0], pA0); pA1 = H4_MFMA(b1, qr[d0], pA1); } } }
        H4_CMASK(pA0, pA1, 0);
        asm volatile("s_nop 15\n\ts_nop 7" : "+v"(pA0), "+v"(pA1));
        { float a = max3f(pA0[0], pA0[1], pA1[0]), bq = max3f(pA0[2], pA0[3], pA1[1]); a = max3f(a, pA1[2], pA1[3]);
#pragma unroll
          for (int r = 4; r < 16; r += 4) { a = max3f(a, pA0[r], pA0[r + 1]); bq = max3f(bq, pA0[r + 2], pA0[r + 3]); a = max3f(a, pA1[r], pA1[r + 1]); bq = max3f(bq, pA1[r + 2], pA1[r + 3]); }
          float rm = fmaxf(a, bq); { auto rr = __builtin_amdgcn_permlane32_swap(__float_as_uint(rm), __float_as_uint(rm), false, false); rm = fmaxf(__uint_as_float(rr[0]), __uint_as_float(rr[1])); }
          mhat = rm;
#pragma unroll
          for (int r = 0; r < 16; ++r) { pA0[r] = fast_exp2(pA0[r] - rm); pA1[r] = fast_exp2(pA1[r] - rm); negm[r] = -rm; }
          H4_PIN(negm); }
        H4_WAIT_BAR(0);
        if (F.tid == 0) *redo_flag = 0u;
        H4_DMA_K(3, 3); H4_DMA_V(1, 1);
        H4_ROT();
        bf16x8 kf[12];
#pragma unroll
        for (int j = 0; j < 4; ++j) { kf[2 * j] = *(const LAS bf16x8*)(kp0 + kc * H4_KS + j * 2048); kf[2 * j + 1] = *(const LAS bf16x8*)(kp0 + kc * H4_KS + j * 2048 + 512); }
        H4_WAIT3();
        s16x4 vlo[4], vhi[4]; u32x4 pw0, pw1, pw2, pw3;
#define H4_PKW(P, B) pk2(P[B], P[B + 1])
#define H4_PAF(k) __builtin_bit_cast(bf16x8, pw##k)
#define H4_VFR(s_) (bf16x8){vlo[s_][0], vlo[s_][1], vlo[s_][2], vlo[s_][3], vhi[s_][0], vhi[s_][1], vhi[s_][2], vhi[s_][3]}
#define H4_MX3(a, b, c) __builtin_fmaxf(__builtin_fmaxf((a), (b)), (c))
#define H4_GAPA(MF, A0, A1, A2, A3, W0, W1, PW) do { MF; sacc += A0; sacc += A1; sacc += A2; sacc += A3; H4_PIN(sacc); W0; W1; H4_PIN(PW); H4_SB(); } while (0)
#define H4_GAPM(MF) do { MF; H4_SB(); } while (0)
#define H4_GAPB(MF, X, B) do { MF; X[B] = fast_exp2(X[B]); X[B + 1] = fast_exp2(X[B + 1]); X[B + 2] = fast_exp2(X[B + 2]); X[B + 3] = fast_exp2(X[B + 3]); H4_PIN(X); H4_SB(); } while (0)
#define H4_VRD(s_, i) do { vlo[s_] = H4_VTR(vp_ + (((i) >> 2) * 4096 + ((i) & 3) * 1024)); vhi[s_] = H4_VTR(vp_ + (((i) >> 2) * 4096 + ((i) & 3) * 1024 + 512)); } while (0)
#define H4_KRD(G, j) do { if (G) { kf[2 * (j)] = *(const LAS bf16x8*)(kn_ + (j) * 2048); kf[2 * (j) + 1] = *(const LAS bf16x8*)(kn_ + (j) * 2048 + 512); H4_SB(); } } while (0)
#define H4_KRR(j) do { kf[2 * (j)] = *(const LAS bf16x8*)(kc_ + (j) * 2048); kf[2 * (j) + 1] = *(const LAS bf16x8*)(kc_ + (j) * 2048 + 512); } while (0)
#define H4_STEP(C0, C1, P0, P1, t, GK, GV, GL, BAND) do { H4_SB(); \
        const LAS unsigned char* vp_ = vp0 + sp * H4_VS; const LAS unsigned char* kn_ = kp0 + ((kc + 1) & 3) * H4_KS; const LAS unsigned char* kc_ = kp0 + kc * H4_KS; \
        float sacc = (P0[0] + P0[1]); \
        H4_GAPA(C0 = H4_MFMA(kf[0], qr[0], negm), P0[2], P0[3], P0[4], P0[5],     pw0[0] = H4_PKW(P0, 0), pw0[1] = H4_PKW(P0, 2), pw0); \
        H4_GAPA(C1 = H4_MFMA(kf[1], qr[0], negm), P0[6], P0[7], P0[8], P0[9],     pw0[2] = H4_PKW(P0, 4), pw0[3] = H4_PKW(P0, 6), pw0); \
        H4_GAPA(C0 = H4_MFMA(kf[2], qr[1], C0),   P0[10], P0[11], P0[12], P0[13], pw1[0] = H4_PKW(P0, 8), pw1[1] = H4_PKW(P0, 10), pw1); \
        H4_GAPA(C1 = H4_MFMA(kf[3], qr[1], C1),   P0[14], P0[15], P1[0], P1[1],   pw1[2] = H4_PKW(P0, 12), pw1[3] = H4_PKW(P0, 14), pw1); \
        H4_KRR(4); H4_SB(); H4_GAPA(C0 = H4_MFMA(kf[4], qr[2], C0),   P1[2], P1[3], P1[4], P1[5],     pw2[0] = H4_PKW(P1, 0), pw2[1] = H4_PKW(P1, 2), pw2); \
        H4_KRR(5); H4_SB(); H4_GAPA(C1 = H4_MFMA(kf[5], qr[2], C1),   P1[6], P1[7], P1[8], P1[9],     pw2[2] = H4_PKW(P1, 4), pw2[3] = H4_PKW(P1, 6), pw2); \
        H4_VRD(0, 0); H4_SB(); H4_GAPA(C0 = H4_MFMA(kf[6], qr[3], C0),   P1[10], P1[11], P1[12], P1[13], pw3[0] = H4_PKW(P1, 8), pw3[1] = H4_PKW(P1, 10), pw3); \
        H4_VRD(1, 4); H4_SB(); H4_GAPA(C1 = H4_MFMA(kf[7], qr[3], C1),   P1[14], P1[15], 0.f, 0.f,       pw3[2] = H4_PKW(P1, 12), pw3[3] = H4_PKW(P1, 14), pw3); \
        H4_VRD(2, 1); H4_KRD(GL, 0); H4_SB(); H4_GAPM(C0 = H4_MFMA(kf[8], qr[4], C0)); H4_VRD(3, 5); H4_KRD(GL, 1); H4_SB(); H4_GAPM(C1 = H4_MFMA(kf[9], qr[4], C1)); if (GK) { H4_DMA_K((t) + 3, (kc + 3) & 3); H4_SB(); } \
        H4_KRD(GL, 2); H4_GAPM(C0 = H4_MFMA(kf[10], qr[5], C0)); if (GV) { H4_DMA_V((t) + 1, sn); H4_SB(); } \
        H4_KRD(GL, 3); H4_GAPM(C1 = H4_MFMA(kf[11], qr[5], C1)); \
        l_reg += sacc; \
        if (BAND) H4_CMASK(C0, C1, t); \
        resc = false; \
        if (safe) { float a = H4_MX3(C0[0], C0[1], C1[0]), bq = H4_MX3(C0[2], C0[3], C1[1]); a = H4_MX3(a, C1[2], C1[3]); \
          _Pragma("unroll") for (int r = 4; r < 16; r += 4) { a = H4_MX3(a, C0[r], C0[r + 1]); bq = H4_MX3(bq, C0[r + 2], C0[r + 3]); a = H4_MX3(a, C1[r], C1[r + 1]); bq = H4_MX3(bq, C1[r + 2], C1[r + 3]); } \
          float rm = __builtin_fmaxf(a, bq); { auto rr = __builtin_amdgcn_permlane32_swap(__float_as_uint(rm), __float_as_uint(rm), false, false); rm = __builtin_fmaxf(__uint_as_float(rr[0]), __uint_as_float(rr[1])); } \
          if (__builtin_expect(__any(rm > 8.f), 0)) { const float dl = __builtin_fmaxf(rm, 0.f); mhat += dl; \
              _Pragma("unroll") for (int r = 0; r < 16; ++r) { C0[r] -= dl; C1[r] -= dl; } \
              _Pragma("unroll") for (int r = 0; r < 16; ++r) negm[r] = -mhat; H4_PIN(negm); \
              const float f = fast_exp2(-dl); l_reg *= f; if (hi == 0) { int ri_ = threadIdx.x & 31; asm volatile("" : "+v"(ri_)); wsf[ri_] = f; } resc = true; } } \
        H4_SB(); \
        H4_GAPB(o[0] = H4_MFMA(H4_PAF(0), H4_VFR(0), o[0]), C0, 0); \
        H4_VRD(0, 2); H4_SB(); H4_GAPB(o[1] = H4_MFMA(H4_PAF(0), H4_VFR(1), o[1]), C0, 4); \
        H4_VRD(1, 6); H4_SB(); H4_GAPB(o[0] = H4_MFMA(H4_PAF(1), H4_VFR(2), o[0]), C0, 8); \
        H4_VRD(2, 3); H4_SB(); H4_GAPB(o[1] = H4_MFMA(H4_PAF(1), H4_VFR(3), o[1]), C0, 12); \
        H4_VRD(3, 7); H4_SB(); H4_GAPB(o[0] = H4_MFMA(H4_PAF(2), H4_VFR(0), o[0]), C1, 0); \
        H4_GAPB(o[1] = H4_MFMA(H4_PAF(2), H4_VFR(1), o[1]), C1, 4); \
        H4_GAPB(o[0] = H4_MFMA(H4_PAF(3), H4_VFR(2), o[0]), C1, 8); \
        H4_GAPB(o[1] = H4_MFMA(H4_PAF(3), H4_VFR(3), o[1]), C1, 12); \
        } while (0)
        int t = 1;
        for (; t + 5 < NT; t += 2) {
            H4_STEP(pB0, pB1, pA0, pA1, t, true, true, true, false);     H4_WAIT3(); H4_RESC(); H4_ROT();
            H4_STEP(pA0, pA1, pB0, pB1, t + 1, true, true, true, false); H4_WAIT3(); H4_RESC(); H4_ROT();
        }
#define H4_ENDW(tt) do { if ((tt) + 3 < NT) { H4_WAIT3(); } else if ((tt) + 2 < NT) { H4_WAIT_BAR(1); } else { H4_WAIT_BAR(0); } } while (0)
        for (; t + 1 < NT; t += 2) {
            H4_STEP(pB0, pB1, pA0, pA1, t, (t + 3 < NT), (t + 1 < NT), (t + 1 < NT), true);         H4_ENDW(t);     H4_RESC(); H4_ROT();
            H4_STEP(pA0, pA1, pB0, pB1, t + 1, (t + 4 < NT), (t + 2 < NT), (t + 2 < NT), true);     H4_ENDW(t + 1); H4_RESC(); H4_ROT();
        }
        H4_STEP(pB0, pB1, pA0, pA1, NT - 1, false, false, false, true); H4_RESC();
        { float sacc = pB0[0] + pB0[1];
#pragma unroll
          for (int r = 2; r < 16; ++r) sacc += pB0[r];
#pragma unroll
          for (int r = 0; r < 16; ++r) sacc += pB1[r];
          l_reg += sacc;
          u32x4 pw[4];
          pw[0] = (u32x4){H4_PKW(pB0, 0), H4_PKW(pB0, 2), H4_PKW(pB0, 4), H4_PKW(pB0, 6)}; pw[1] = (u32x4){H4_PKW(pB0, 8), H4_PKW(pB0, 10), H4_PKW(pB0, 12), H4_PKW(pB0, 14)};
          pw[2] = (u32x4){H4_PKW(pB1, 0), H4_PKW(pB1, 2), H4_PKW(pB1, 4), H4_PKW(pB1, 6)}; pw[3] = (u32x4){H4_PKW(pB1, 8), H4_PKW(pB1, 10), H4_PKW(pB1, 12), H4_PKW(pB1, 14)};
          H4_SB(); mla_pv(o, pw, lds + H4_V + sc * H4_VS, lane, hi); }
#undef H4_DMA_K
#undef H4_DMA_V
#undef H4_ROT
#undef H4_CMASK
#undef H4_RESC
#undef H4_PKW
#undef H4_PAF
#undef H4_VFR
#undef H4_MX3
#undef H4_GAPA
#undef H4_GAPM
#undef H4_GAPB
#undef H4_VRD
#undef H4_KRD
#undef H4_KRR
#undef H4_STEP
#undef H4_ENDW
        int le_ = threadIdx.x & 63; asm volatile("" : "+v"(le_));
        if (__any(!(l_reg < 1e18f)) && le_ == 0) *redo_flag = 1u;
        (void)att::finish_rows(o, l_reg, wsf, stg, le_ & 31, le_ >> 5);
        bf16_t* ob = O + (rowb + q0 + 32 * wid) * DM + h * 64;
#pragma unroll
        for (int i2 = 0; i2 < 4; ++i2) { const int row = i2 * 8 + (le_ >> 3), ch = le_ & 7; const u32x4 v = *(const LAS u32x4*)(stg + row * 64 + ch * 8); *(u32x4*)(ob + (size_t)row * DM + ch * 8) = v; }
        ATT_WAIT_BAR(0);
        const unsigned redo = __builtin_amdgcn_readfirstlane(*redo_flag);
        if (safe || redo == 0u) break;
        safe = true;
        }
    }
#undef H4_SB
#undef H4_PIN
#undef H4_WAIT_BAR
#undef H4_WAIT3
#undef H4_VTR
#undef H4_MFMA
#undef H4_Z
}

__device__ __forceinline__ void router_pass(const Frame& F, const bf16_t* xb, const float* g, const float* wrouter, float* r3, int* e01, float* gwt, int* cnt, int* list, float* rsrow, unsigned* x8) {
    LAS float* wr = (LAS float*)F.lds;
    LAS int* lc = (LAS int*)(F.lds + 32768);
    for (int i = F.tid; i < DM * NEXP / 4; i += NWAVES * 64) ((LAS f32x4*)wr)[i] = ((const f32x4*)wrouter)[i];
    for (int i = F.bid * NWAVES * 64 + F.tid; i < 2 * MOE_MAXROWS; i += F.G * NWAVES * 64) { list[i] = -1; rsrow[i] = 1.f; }
    f32x4 gv[4]; load_gain(g, gv, F.lane);
    const int lane = F.lane;
    for (int ch = F.bid; ch < T / 128; ch += F.G) {
        if (F.tid < 16) lc[F.tid] = 0;
        __syncthreads();
        f32x4 v[4]; u32x2 vn[4];
        { const u32x2* xr = (const u32x2*)(xb + (size_t)(ch * 128 + F.wave * 16) * DM) + lane;
#pragma unroll
          for (int j = 0; j < 4; ++j) vn[j] = xr[64 * j]; }
        for (int rr = 0; rr < 16; ++rr) {
            const int m = ch * 128 + F.wave * 16 + rr;
#pragma unroll
            for (int j = 0; j < 4; ++j) v[j] = (f32x4){bflo(vn[j].x), bfhi(vn[j].x), bflo(vn[j].y), bfhi(vn[j].y)};
            { const int mn = rr < 15 ? m + 1 : m; const u32x2* xr = (const u32x2*)(xb + (size_t)mn * DM) + lane;
#pragma unroll
              for (int j = 0; j < 4; ++j) vn[j] = xr[64 * j]; }
            __builtin_amdgcn_sched_barrier(0);
            { float s = 0.f;
#pragma unroll
              for (int j = 0; j < 4; ++j) s += (v[j].x * v[j].x + v[j].y * v[j].y) + (v[j].z * v[j].z + v[j].w * v[j].w);
              const float r = __builtin_amdgcn_rsqf(wave_sum(s) * (1.f / DM) + RMS_EPS);
              if (lane == 0) r3[m] = r;
#pragma unroll
              for (int j = 0; j < 4; ++j) x8[(size_t)m * (DM / 4) + 64 * j + lane] = pk4_fp8(v[j].x * 2.f, v[j].y * 2.f, v[j].z * 2.f, v[j].w * 2.f);
#pragma unroll
              for (int j = 0; j < 4; ++j) v[j] = v[j] * r * gv[j]; }
            float lg[NEXP];
#pragma unroll
            for (int e = 0; e < NEXP; ++e) lg[e] = 0.f;
#pragma unroll
            for (int j = 0; j < 4; ++j)
#pragma unroll
                for (int k = 0; k < 4; ++k) { const int col = 4 * (64 * j + lane) + k; const f32x4 w0 = *(const LAS f32x4*)(wr + col * 8), w1 = *(const LAS f32x4*)(wr + col * 8 + 4); const float xv = v[j][k];
                    lg[0] += xv * w0.x; lg[1] += xv * w0.y; lg[2] += xv * w0.z; lg[3] += xv * w0.w; lg[4] += xv * w1.x; lg[5] += xv * w1.y; lg[6] += xv * w1.z; lg[7] += xv * w1.w; }
#pragma unroll
            for (int e = 0; e < NEXP; ++e) lg[e] = wave_sum(lg[e]);
            int i0 = 0; float b0 = lg[0];
#pragma unroll
            for (int e = 1; e < NEXP; ++e) if (lg[e] > b0) { b0 = lg[e]; i0 = e; }
            int i1 = -1; float b1 = -INFINITY;
#pragma unroll
            for (int e = 0; e < NEXP; ++e) if (e != i0 && lg[e] > b1) { b1 = lg[e]; i1 = e; }
            const float w1 = 1.f / (1.f + expf(b0 - b1)), w0 = 1.f - w1;
            if (lane == 0) { e01[m] = i0 | (i1 << 8); gwt[2 * m] = w0; gwt[2 * m + 1] = w1; lds_add(&lc[i0], 1); lds_add(&lc[8 + i1], 1); }
        }
        __syncthreads();
        if (F.tid < 16) cnt[ch * 16 + F.tid] = lc[F.tid];
        __syncthreads();
    }
}
__device__ __forceinline__ void list_pass(const Frame& F, const int* e01, const float* gwt, const int* cnt, int* list, float* gws, int* bases, const float* r3, float* rsrow) {
    LAS int* tot = (LAS int*)F.lds;
    LAS int* pre = tot + 16;
    LAS int* lc = tot + 32;
    LAS int* bs = tot + 48;
    constexpr int NCH = T / 128;
    for (int ch = F.bid; ch < NCH; ch += F.G) {
        if (F.tid < 64) tot[F.tid] = 0;
        __syncthreads();
        for (int i = F.tid; i < NCH * 16; i += NWAVES * 64) { const int c = cnt[i]; lds_add(&tot[i & 15], c); if ((i >> 4) < ch) lds_add(&pre[i & 15], c); }
        __syncthreads();
        if (F.tid < 2) { int acc = 0; for (int e = 0; e < NEXP; ++e) { bs[F.tid * 9 + e] = acc; acc += (tot[F.tid * 8 + e] + 255) & ~255; } bs[F.tid * 9 + 8] = acc; }
        __syncthreads();
        if (ch == 0 && F.tid < 18) bases[F.tid] = bs[F.tid];
        if (F.tid < 128) {
            const int m = ch * 128 + F.tid; const int ee = e01[m]; const int i0 = ee & 255, i1 = ee >> 8;
            const int p0 = lds_add(&lc[i0], 1), p1 = lds_add(&lc[8 + i1], 1);
            const int s0 = bs[i0] + pre[i0] + p0, s1 = bs[9 + i1] + pre[8 + i1] + p1;
            list[s0] = m; gws[s0] = gwt[2 * m] * (1.f / 512.f); list[MOE_MAXROWS + s1] = m; gws[MOE_MAXROWS + s1] = gwt[2 * m + 1] * (1.f / 512.f);
            const float rt = r3[m] * (1.f / 128.f); rsrow[s0] = rt; rsrow[MOE_MAXROWS + s1] = rt;
        }
        __syncthreads();
    }
}

#ifndef PHASE_MASK
#define PHASE_MASK 0xFFFFFFFFu
#endif
#define PH(n) (((PHASE_MASK) >> (n)) & 1u)
__global__ void __launch_bounds__(NWAVES * 64, 2) trunk_fwd(Args args) {
    extern __shared__ __attribute__((aligned(16))) unsigned char lds_raw[];
    Frame F;
    F.lds = (LAS unsigned char*)lds_raw;
    volatile LAS unsigned* MISC = (volatile LAS unsigned*)(F.lds + MISC_OFF);
    F.tid = threadIdx.x; F.lane = F.tid & 63; F.wave = __builtin_amdgcn_readfirstlane(F.tid >> 6);
    F.G = gridDim.x; F.bid = blockIdx.x;
    unsigned char* ws = args.ws;
    for (int u = F.tid; u < (LDS_BYTES - MISC_OFF) / 4; u += NWAVES * 64) ((LAS unsigned*)(F.lds + MISC_OFF))[u] = 0u;
    __syncthreads();
    XcdBarrier bar = xcd_barrier_post((unsigned*)(ws + WS_CTL) + CW_BAR, MISC + 8);
#define GRID_BAR() xcd_barrier(bar)

    const float* x = (const float*)args.in[0]; const int* positions = (const int*)args.in[1];
    const float* mix_g = (const float*)args.in[2]; const float* ffn_g = (const float*)args.in[3];
    float* out = args.out;
    bf16_t* Wqkv = (bf16_t*)(ws + WS_WQKV); bf16_t* Woa = (bf16_t*)(ws + WS_WOA); bf16_t* Wgu0 = (bf16_t*)(ws + WS_WGU0); bf16_t* Wd0 = (bf16_t*)(ws + WS_WD0);
    bf16_t* Win = (bf16_t*)(ws + WS_WIN); bf16_t* Wqup = (bf16_t*)(ws + WS_WQUP); bf16_t* Wkvup = (bf16_t*)(ws + WS_WKVUP); bf16_t* Wob = (bf16_t*)(ws + WS_WOB);
    bf16_t* Wmgu = (bf16_t*)(ws + WS_MOEGU); bf16_t* Wmd = (bf16_t*)(ws + WS_MOED);
    bf16_t* HN = (bf16_t*)(ws + WS_HN); bf16_t* QKV = (bf16_t*)(ws + WS_QKV); bf16_t* O3 = (bf16_t*)(ws + WS_O3); bf16_t* MIX = (bf16_t*)(ws + WS_MIX); bf16_t* ACT0 = (bf16_t*)(ws + WS_ACT0);
    bf16_t* CQ = (bf16_t*)(ws + WS_CQ); bf16_t* CKV = (bf16_t*)(ws + WS_CKV); bf16_t* KR = (bf16_t*)(ws + WS_KR);
    bf16_t* Qb = (bf16_t*)(ws + WS_Q); bf16_t* KVb = (bf16_t*)(ws + WS_KV); bf16_t* Ob = (bf16_t*)(ws + WS_O); bf16_t* ACTE = (bf16_t*)(ws + WS_ACTE);
    float* SSL = (float*)(ws + WS_SSL); float* SSQ = (float*)(ws + WS_SSQ); bf16_t* XB2 = (bf16_t*)(ws + WS_MOEGU); bf16_t* HN8 = (bf16_t*)(ws + WS_HN8); float* RS = (float*)(ws + WS_RS); float* RSROW = (float*)(ws + WS_RSROW); bf16_t* XB1 = (bf16_t*)(ws + WS_XB1);
    float* COS = (float*)(ws + WS_COS); float* SIN = (float*)(ws + WS_SIN); float* LSE = (float*)(ws + WS_LSE);
    int* E01 = (int*)(ws + WS_E01); float* GWT = (float*)(ws + WS_GWT); int* LIST = (int*)(ws + WS_LIST); float* GWS = (float*)(ws + WS_GWS); int* CNT = (int*)(ws + WS_CNT); int* BASES = (int*)(ws + WS_BASES);
    const int gw = F.bid * NWAVES + F.wave, NGW = F.G * NWAVES;
    LAS float* scr = (LAS float*)(F.lds + F.wave * 16384);
    LAS unsigned char* scr8 = F.lds + F.wave * 16384;

    if (PH(0)) { const Frame FL = phase_frame(F);
        constexpr int I_QKV = 16 * 72, I_OA = 8 * 16, I_GU0 = 16 * 88, I_D0 = 44 * 16, I_IN = 16 * 24, I_QUP = 6 * 48, I_KVUP = 4 * 32, I_OB = 16 * 16;
        constexpr int NITEMS = I_QKV + I_OA + I_GU0 + I_D0 + I_IN + I_QUP + I_KVUP + I_OB;
        for (int it = gw; it < NITEMS; it += NGW) {
            int r = it;
            if (r < I_QKV) { tr_plain64((const float*)args.in[4], DM, QKVC, Wqkv, scr8, r, FL.lane); continue; } r -= I_QKV;
            if (r < I_OA) { tr_plain64((const float*)args.in[5], DSAW, DM, Woa, scr8, r, FL.lane); continue; } r -= I_OA;
            if (r < I_GU0) { tr_gateup64<true>((const float*)args.in[12], (const float*)args.in[13], DM, FF0, Wgu0, scr8, r, FL.lane, ffn_g); continue; } r -= I_GU0;
            if (r < I_D0) { tr_plain64((const float*)args.in[14], FF0, DM, Wd0, scr8, r, FL.lane); continue; } r -= I_D0;
            if (r < I_IN) { const int nblk = MLA_INP / 32, kb = r / nblk, nb = r % nblk; const int p_ = FL.lane & 31;
                tr_item((const float*)args.in[6], MLA_IN, 64 * kb, 32 * nb < QL + KVL ? 32 * nb + p_ : (32 * nb == QL + KVL ? QL + KVL + (p_ & 1) * 16 + (p_ >> 1) : -1), Win, DM, 32 * nb, scr, FL.lane, mix_g + DM); continue; } r -= I_IN;
            if (r < I_QUP) { const int nblk = QC / 32, kb = r / nblk, nb = r % nblk, n0 = 32 * nb, hh = n0 / HQ, cc = n0 % HQ; const int p = FL.lane & 31;
                const int scol = cc < 64 ? n0 + p : hh * HQ + 64 + (p & 1) * 16 + (p >> 1);
                tr_item((const float*)args.in[9], QC, 64 * kb, scol, Wqup, QL, n0, scr, FL.lane, (const float*)args.in[7]); continue; } r -= I_QUP;
            if (r < I_KVUP) { tr_plain64<true>((const float*)args.in[10], KVL, KVC, Wkvup, scr8, r, FL.lane, (const float*)args.in[8]); continue; } r -= I_KVUP;
            tr_plain64((const float*)args.in[11], DM, DM, Wob, scr8, r, FL.lane);
        }
        norm_pass(phase_frame(F), x, mix_g, HN);
        for (int i = F.bid * NWAVES * 64 + F.tid; i < T * 16; i += F.G * NWAVES * 64) { const int m = i >> 4, k = i & 15;
            float sk, ck; sincosf((float)positions[m] * powf(10000.0f, -(float)k / 16.0f), &sk, &ck); COS[i] = ck; SIN[i] = sk; }
    }
    GRID_BAR();
    if (PH(1)) { pg::StaticOrder S; S.init(T, QKVC, F.G, F.bid); pg::EpiQKV E{QKV, C2_DSA};
      pg::gemm_phase<pg::EpiQKV, pg::StaticOrder, false>(F.lds, HN, Wqkv, DM, DM, nullptr, S, E); }
    GRID_BAR();
    if (PH(2)) dilated_phase(phase_frame(F), QKV, positions, O3, LSE);
    GRID_BAR();
    if (PH(3)) merge_pass(phase_frame(F), O3, LSE, MIX);
    GRID_BAR();
    if (PH(4)) { pg::StaticOrder S; S.init(T, DM, F.G, F.bid); pg::EpiResBf<true, false> E{x, nullptr, XB1, SSQ};
      pg::gemm_phase<pg::EpiResBf<true, false>, pg::StaticOrder, false>(F.lds, MIX, Woa, DSAW, DSAW, nullptr, S, E); }
    GRID_BAR();
    if (PH(5)) { const Frame FL = phase_frame(F);
        for (int row = F.bid * NWAVES * 64 + F.tid; row < T; row += F.G * NWAVES * 64) RS[row] = pg::row_rrms(SSQ, row);
    }
    GRID_BAR();
    if (PH(6)) { pg::StaticOrder S; S.init(T, 2 * FF0, F.G, F.bid); pg::EpiSwiGLUT<1> E{ACT0, FF0, RS};
      pg::gemm_phase<pg::EpiSwiGLUT<1>, pg::StaticOrder, false>(F.lds, XB1, Wgu0, DM, DM, nullptr, S, E);
    }
    GRID_BAR();
    if (PH(7)) { pg::StaticOrder S; S.init(T, DM, F.G, F.bid); pg::EpiResBf<false, false> E{XB1, nullptr, XB2, SSQ};
      pg::gemm_phase<pg::EpiResBf<false, false>, pg::StaticOrder, false>(F.lds, ACT0, Wd0, FF0, FF0, nullptr, S, E); }
    GRID_BAR();
    if (PH(9)) { pg::StaticOrder S; S.init(T, MLA_INP, F.G, F.bid); pg::EpiLat E{CQ, CKV, KR, SSQ, SSL, COS, SIN};
      pg::gemm_phase<pg::EpiLat, pg::StaticOrder, false>(F.lds, XB2, Win, DM, DM, nullptr, S, E); }
    GRID_BAR();
    if (PH(11)) { pg::StaticOrder S; S.init(T, QC, F.G, F.bid); pg::EpiQRope E{Qb, COS, SIN, SSL};
      pg::gemm_phase<pg::EpiQRope, pg::StaticOrder, false>(F.lds, CQ, Wqup, QL, QL, nullptr, S, E); }
    if (PH(12)) { pg::StaticOrder S; S.init(T, KVC, F.G, F.bid); pg::EpiKVScale E{KVb, KVC, SSL};
      pg::gemm_phase<pg::EpiKVScale, pg::StaticOrder, false>(F.lds, CKV, Wkvup, KVL, KVL, nullptr, S, E); }
    GRID_BAR();
    if (PH(13)) mla_attn_phase4(phase_frame(F), Qb, KVb, KR, Ob);
    GRID_BAR();
    if (PH(14)) { pg::StaticOrder S; S.init(T, DM, F.G, F.bid); pg::EpiResBf<false, false> E{XB2, nullptr, HN, SSQ};
      pg::gemm_phase<pg::EpiResBf<false, false>, pg::StaticOrder, false>(F.lds, Ob, Wob, DM, DM, nullptr, S, E); }
    GRID_BAR();
    if (PH(15)) { router_pass(phase_frame(F), HN, ffn_g + DM, (const float*)args.in[15], RS, E01, GWT, CNT, LIST, RSROW, (unsigned*)HN8);
        __syncthreads();
        const Frame FL = phase_frame(F);
        constexpr int I_GU = 16 * 112, I_D = 56 * 16, I_E = I_GU + I_D;
        for (int it = gw; it < NEXP * I_E; it += NGW) {
            const int e = it / I_E; int r = it % I_E;
            if (r < I_GU) tr_gateup64<true, true>((const float*)args.in[16] + (size_t)e * DM * FFE, (const float*)args.in[17] + (size_t)e * DM * FFE, DM, FFE, Wmgu + (size_t)e * FFE * DM, scr8, r, FL.lane, ffn_g + DM);
            else tr_plain64<false, true>((const float*)args.in[18] + (size_t)e * FFE * DM, FFE, DM, Wmd + (size_t)e * DM * FFE / 2, scr8, r - I_GU, FL.lane);
        }
    }
    GRID_BAR();
    if (PH(16)) list_pass(phase_frame(F), E01, GWT, CNT, LIST, GWS, BASES, RS, RSROW);
    GRID_BAR();
    {
        typedef pg::MoeOrder<2 * FFE / 256, 1, (long)FFE * DM> OrdGU;     typedef pg::MoeOrder<DM / 256, 1, (long)DM * FFE / 2> OrdDown; typedef pg::MoeOrder<DM / 256, MOE_TAIL_SPLIT, (long)DM * FFE / 2> OrdTail;
        const int nT0 = __builtin_amdgcn_readfirstlane(BASES[NEXP]) / 256, nT1 = __builtin_amdgcn_readfirstlane(BASES[9 + NEXP]) / 256, tmain = (2 * F.G) / 4;
#define MOE_BASES(S_, r_) do { _Pragma("unroll") for (int q_ = 0; q_ <= NEXP; ++q_) S_.base[q_] = __builtin_amdgcn_readfirstlane(BASES[(r_) * 9 + q_]); } while (0)
        const int tm0 = nT0 < tmain ? nT0 : tmain, tm1 = nT1 < tmain ? nT1 : tmain;
        const int off0 = ((((nT0 * (2 * FFE / 256)) % F.G) + 7) & ~7) % F.G;
        const int nq0 = (nT0 > tmain ? nT0 - tmain : 0) * (DM / 256) * MOE_TAIL_SPLIT;
        const int nq1 = (nT1 > tmain ? nT1 - tmain : 0) * (DM / 256) * MOE_TAIL_SPLIT;
        bf16_t* T1p = (bf16_t*)((ws + 1 * MiB) - (size_t)tmain * 256 * FFE);
#pragma unroll 1
        for (int k = 0; k < 3; ++k) {
            if (k == 2) {
                GRID_BAR();
                for (int r = tmain * 256 + gw; r < nT0 * 256; r += NGW) { const int tok = LIST[r];
                    if (tok >= 0) { const u32x2* xr = (const u32x2*)(HN + (size_t)tok * DM) + F.lane; f32x4* orow = (f32x4*)(out + (size_t)tok * DM) + F.lane;
#pragma unroll
                        for (int j = 0; j < 4; ++j) { const u32x2 w = xr[64 * j]; orow[64 * j] = (f32x4){bflo(w.x), bfhi(w.x), bflo(w.y), bfhi(w.y)}; } } }
                { OrdDown S; S.G = F.G; S.c = F.bid; MOE_BASES(S, 0);
                  S.t0 = 0; S.t1 = tm0; S.klen = 0;
                  pg::EpiMoeDown E{out, LIST, GWS, HN};
                  pg::gemm_phase<pg::EpiMoeDown, OrdDown, false, true, 0, 0>(F.lds, ACTE, Wmd, FFE / 2, FFE / 2, nullptr, S, E); }
                GRID_BAR();
#pragma unroll 1
                for (int r = 0; r < 2; ++r) {
                    OrdTail S; S.G = F.G; S.c = r == 0 ? F.bid : (F.bid - (nq0 % F.G) + F.G) % F.G; MOE_BASES(S, r);
                    S.t0 = tmain; S.t1 = r == 0 ? nT0 : nT1; S.klen = FFE / 2 / MOE_TAIL_SPLIT;
                    pg::EpiMoeDownAtomic E{out, LIST + r * MOE_MAXROWS, GWS + r * MOE_MAXROWS};
                    pg::gemm_phase<pg::EpiMoeDownAtomic, OrdTail, false, true, 0, 0>(F.lds, r == 0 ? ACTE : T1p, Wmd, FFE / 2 / MOE_TAIL_SPLIT, FFE / 2, nullptr, S, E);
                }
            }
            OrdGU S; S.G = F.G; S.c = k == 1 ? (F.bid - off0 + F.G) % F.G : F.bid; MOE_BASES(S, k == 0 ? 0 : 1);
            S.t0 = k == 1 ? tmain : 0; S.t1 = k == 0 ? nT0 : (k == 1 ? nT1 : tm1); S.klen = 0;
            if (k == 2) { const int nwg = tm1 * (2 * FFE / 256), ntc = nq0 + nq1;
                int Gm = F.G; asm volatile("" : "+s"(Gm));
                if (nwg % Gm == 0 && nwg >= 2 * Gm && ntc > 0 && 2 * ntc <= Gm) { S.rd_ntc = ntc; S.rd_R = nwg / Gm - 2; } }
            pg::EpiSwiGLU E{k == 1 ? T1p : ACTE, FFE, RSROW + (k == 0 ? 0 : MOE_MAXROWS)};
            pg::gemm_phase<pg::EpiSwiGLU, OrdGU, true, true, 0, 0>(F.lds, HN8, Wmgu, DM / 2, DM / 2, LIST + (k == 0 ? 0 : MOE_MAXROWS), S, E);
        }
        GRID_BAR();
        { OrdDown S; S.G = F.G; S.c = F.bid; MOE_BASES(S, 1);
          S.t0 = 0; S.t1 = tm1; S.klen = 0;
          pg::EpiMoeDown E{out, LIST + MOE_MAXROWS, GWS + MOE_MAXROWS, nullptr};
          pg::gemm_phase<pg::EpiMoeDown, OrdDown, false, true, 0, 0>(F.lds, ACTE, Wmd, FFE / 2, FFE / 2, nullptr, S, E); }
        GRID_BAR();
#undef MOE_BASES
    }
    if (PH(19)) { const Frame FL = phase_frame(F);
        f32x4 gv[4]; load_gain((const float*)args.in[19], gv, FL.lane);
        f32x4 v[4], vn[4];
        if (gw < T) { const f32x4* xr = (const f32x4*)(out + (size_t)gw * DM) + FL.lane;
#pragma unroll
            for (int j = 0; j < 4; ++j) v[j] = xr[64 * j]; }
        for (int m = gw; m < T; m += NGW) {
            const int mn = m + NGW < T ? m + NGW : m;
            { const f32x4* xr = (const f32x4*)(out + (size_t)mn * DM) + FL.lane;
#pragma unroll
              for (int j = 0; j < 4; ++j) vn[j] = xr[64 * j]; }
            __builtin_amdgcn_sched_barrier(0);
            float s = 0.f;
#pragma unroll
            for (int j = 0; j < 4; ++j) s += (v[j].x * v[j].x + v[j].y * v[j].y) + (v[j].z * v[j].z + v[j].w * v[j].w);
            const float r = __builtin_amdgcn_rsqf(wave_sum(s) * (1.f / DM) + RMS_EPS);
            if (mn == m) {
#pragma unroll
                for (int j = 0; j < 4; ++j) asm volatile("" : "+v"(vn[j])); }
            f32x4* xw = (f32x4*)(out + (size_t)m * DM) + FL.lane;
#pragma unroll
            for (int j = 0; j < 4; ++j) xw[64 * j] = v[j] * r * gv[j];
#pragma unroll
            for (int j = 0; j < 4; ++j) v[j] = vn[j];
        }
    }
}

extern "C" void kernel_launch(void* const* d_in, const int* in_sizes, int n_in, void* d_out, int out_size, void* d_ws, size_t ws_size, hipStream_t stream) {
    static int grid = 0;
    if (grid == 0) {
        if (n_in != 20 || in_sizes[0] != T * DM || out_size != T * DM || ws_size < WS_END) { fprintf(stderr, "kernel_launch: unexpected shapes / workspace (%d inputs, ws %zu < %zu)\n", n_in, ws_size, (size_t)WS_END); grid = -1; return; }
        int dev = 0, cus = 0, per_cu = 0;
        if (hipGetDevice(&dev) != hipSuccess || hipDeviceGetAttribute(&cus, hipDeviceAttributeMultiprocessorCount, dev) != hipSuccess) { grid = -1; return; }
        if (hipFuncSetAttribute((const void*)trunk_fwd, hipFuncAttributeMaxDynamicSharedMemorySize, LDS_BYTES) != hipSuccess) { fprintf(stderr, "kernel_launch: hipFuncSetAttribute failed\n"); grid = -1; return; }
        if (hipOccupancyMaxActiveBlocksPerMultiprocessor(&per_cu, (const void*)trunk_fwd, NWAVES * 64, LDS_BYTES) != hipSuccess || per_cu < 1) { fprintf(stderr, "kernel_launch: occupancy query says %d\n", per_cu); }
        (void)hipGetLastError();
        grid = cus;
    }
    if (grid < 0) return;
    (void)hipMemsetAsync((char*)d_ws + WS_CTL, 0, CTL_ZERO_BYTES, stream);
    Args a{};
    for (int i = 0; i < 20; ++i) a.in[i] = d_in[i];
    a.out = (float*)d_out; a.ws = (unsigned char*)d_ws;
    hipLaunchKernelGGL(trunk_fwd, dim3(grid), dim3(NWAVES * 64), LDS_BYTES, stream, a);
}
```

```cpp
#include <hip/hip_runtime.h>
#include <cstdio>
#include <cstdint>

#define LAS __attribute__((address_space(3)))
#define GAS __attribute__((address_space(1)))
typedef unsigned short bf16_t;
typedef short bf16x8 __attribute__((ext_vector_type(8)));
typedef short s16x4 __attribute__((ext_vector_type(4)));
typedef float f32x2 __attribute__((ext_vector_type(2)));
typedef float f32x4 __attribute__((ext_vector_type(4)));
typedef float f32x16 __attribute__((ext_vector_type(16)));
typedef unsigned u32x2 __attribute__((ext_vector_type(2)));
typedef unsigned u32x4 __attribute__((ext_vector_type(4)));
typedef __bf16 bf16x2_t __attribute__((ext_vector_type(2)));
typedef GAS unsigned gu32;

constexpr int BATCH = 2, SEQ = 16384, T = BATCH * SEQ, DM = 1024;
constexpr int QKVC = 4608;
constexpr int DSAW = 512;
constexpr int FF0 = 2816, FFE = 3584, NEXP = 8;
constexpr int MLA_IN = 672, MLA_INP = 768, QL = 384, KVL = 256, NH = 16, HQ = 96, QC = NH * HQ  , KVC = NH * 128  ;
constexpr float RMS_EPS = 1e-6f;
constexpr float LOG2E = 1.4426950408889634f;
constexpr float C2_DSA = 0.125f * LOG2E;
constexpr float C2_MLA = 0.10206207261596575f * LOG2E;
constexpr int MOE_MAXROWS = T + NEXP * 256;
constexpr int NWAVES = 8;
#ifndef MOE_TAIL_SPLIT
#define MOE_TAIL_SPLIT 2
#endif

constexpr size_t MiB = 1u << 20;
constexpr size_t WS_CTL = 0, CTL_ZERO_BYTES = 1 * MiB;
constexpr size_t WS_WQKV = 1 * MiB, WS_WOA = 10 * MiB, WS_WGU0 = 11 * MiB, WS_WD0 = 22 * MiB, WS_WIN = 28 * MiB, WS_WQUP = 30 * MiB, WS_WKVUP = 32 * MiB, WS_WOB = 33 * MiB;
constexpr size_t WS_COS = 35 * MiB, WS_SIN = 37 * MiB, WS_LSE = 39 * MiB, WS_KR = 42 * MiB;
constexpr size_t WS_SSL = 200 * MiB  ;
constexpr size_t WS_SSQ = 39 * MiB  , WS_RS = 46 * MiB  , WS_RSROW = 46 * MiB + 256 * 1024  , WS_TFLAG = 47 * MiB  , WS_XB1 = 292 * MiB  ;
constexpr size_t WS_E01 = 44 * MiB, WS_GWT = WS_E01 + 128 * 1024, WS_LIST = WS_GWT + 256 * 1024, WS_GWS = WS_LIST + 288 * 1024, WS_CNT = WS_GWS + 288 * 1024, WS_BASES = WS_CNT + 16 * 1024;
constexpr size_t WS_HN = 48 * MiB, WS_QKV = 112 * MiB, WS_O3 = 400 * MiB, WS_MIX = 48 * MiB, WS_ACT0 = 112 * MiB;
constexpr size_t WS_MOEGU = 360 * MiB  , WS_HN8 = 428 * MiB  , WS_MOED = 472 * MiB;
constexpr size_t WS_ALAT = 112 * MiB, WS_CQ = 160 * MiB, WS_CKV = 184 * MiB, WS_Q = 48 * MiB, WS_KV = 232 * MiB, WS_O = 144 * MiB, WS_ACTE = 112 * MiB;
constexpr size_t WS_END = 528 * MiB;
static_assert(WS_BASES + 4096 <= 46 * MiB, "routing tables");
static_assert(WS_ACTE + (size_t)MOE_MAXROWS * FFE * 2 <= WS_MOEGU, "moe act");
static_assert(2 * MOE_MAXROWS * 4 <= 288 * 1024, "list size");
constexpr int CW_BAR = 4096;

constexpr int RING_BYTES = 131072;
constexpr int MISC_OFF = 143360;
constexpr int LDS_BYTES = 147456;

#define RLX_AGENT __ATOMIC_RELAXED, __HIP_MEMORY_SCOPE_AGENT
#define LDS_WAIT() asm volatile("s_waitcnt lgkmcnt(0)" ::: "memory")
#define VM_WAIT() asm volatile("s_waitcnt vmcnt(0)" ::: "memory")
__device__ __forceinline__ unsigned f2bf(float f) { unsigned u = __builtin_bit_cast(unsigned, f); return (u + 0x7fffu + ((u >> 16) & 1u)) >> 16; }
__device__ __forceinline__ unsigned pk2(float lo, float hi) { f32x2 v = {lo, hi}; bf16x2_t b = __builtin_convertvector(v, bf16x2_t); return __builtin_bit_cast(unsigned, b); }
__device__ __forceinline__ unsigned pk4_fp8(float a, float b, float c, float d) { int p_ = __builtin_amdgcn_cvt_pk_fp8_f32(a, b, 0, false); p_ = __builtin_amdgcn_cvt_pk_fp8_f32(c, d, p_, true); return (unsigned)p_; }
__device__ __forceinline__ float bf2f(unsigned short h) { return __builtin_bit_cast(float, (unsigned)h << 16); }
__device__ __forceinline__ float bflo(unsigned w) { return __builtin_bit_cast(float, w << 16); }
__device__ __forceinline__ float bfhi(unsigned w) { return __builtin_bit_cast(float, w & 0xffff0000u); }
__device__ __forceinline__ float wave_sum(float v) {
    int x = __builtin_bit_cast(int, v);
    v += __builtin_bit_cast(float, __builtin_amdgcn_update_dpp(0, x, 0xB1, 0xF, 0xF, true));  x = __builtin_bit_cast(int, v);
    v += __builtin_bit_cast(float, __builtin_amdgcn_update_dpp(0, x, 0x4E, 0xF, 0xF, true));  x = __builtin_bit_cast(int, v);
    v += __builtin_bit_cast(float, __builtin_amdgcn_update_dpp(0, x, 0x141, 0xF, 0xF, true)); x = __builtin_bit_cast(int, v);
    v += __builtin_bit_cast(float, __builtin_amdgcn_update_dpp(0, x, 0x140, 0xF, 0xF, true)); x = __builtin_bit_cast(int, v);
    const float r0 = __builtin_bit_cast(float, __builtin_amdgcn_readlane(x, 0)), r1 = __builtin_bit_cast(float, __builtin_amdgcn_readlane(x, 16));
    const float r2 = __builtin_bit_cast(float, __builtin_amdgcn_readlane(x, 32)), r3 = __builtin_bit_cast(float, __builtin_amdgcn_readlane(x, 48));
    return (r0 + r1) + (r2 + r3);
}
__device__ __forceinline__ int lds_add(LAS int* p, int v) { return __hip_atomic_fetch_add(p, v, __ATOMIC_RELAXED, __HIP_MEMORY_SCOPE_WORKGROUP); }
__device__ __forceinline__ float fast_exp2(float x) { return __builtin_amdgcn_exp2f(x); }
__device__ __forceinline__ float fast_rcp(float x) { return __builtin_amdgcn_rcpf(x); }

#define XB_TMO      128
#define XB_XCNT(j)  (256  + 64 * (j))
#define XB_XSUB(j)  (1280 + 64 * (j))
#define XB_XGEN(j)  (2304 + 64 * (j))
#define XB_TOP      3328
#define XB_TOPGEN   3392
#define XCD_BAR_WORDS 3456
#define XB_SPIN_CAP (1u << 18)
__device__ __forceinline__ unsigned xb_ld(unsigned* p)              { return __hip_atomic_load(p, __ATOMIC_RELAXED, __HIP_MEMORY_SCOPE_AGENT); }
__device__ __forceinline__ unsigned xb_add(unsigned* p, unsigned v) { return __hip_atomic_fetch_add(p, v, __ATOMIC_RELAXED, __HIP_MEMORY_SCOPE_AGENT); }
__device__ __forceinline__ unsigned xb_xcc_id() { return (unsigned)__builtin_amdgcn_s_getreg((3 << 11) | 20) & 0xFu; }
#define XB_SPIN(cond, bar) do { unsigned _sp = 0; while (cond) { __builtin_amdgcn_s_sleep(1); \
    if ((++_sp & 255u) == 0u) { if (xb_ld(&(bar)[XB_TMO])) break; if (_sp > XB_SPIN_CAP) { atomicAdd(&(bar)[XB_TMO], 1u); break; } } } } while (0)
struct XcdBarrier { unsigned* bar; unsigned x; volatile LAS unsigned* st; };
__device__ __forceinline__ XcdBarrier xcd_barrier_post(unsigned* bar, volatile LAS unsigned* st) {
    XcdBarrier b; b.bar = bar; b.x = xb_xcc_id(); b.st = st;
    if (threadIdx.x == 0) (void)xb_add(&bar[XB_XCNT(b.x)], 1u);
    return b;
}
__device__ __forceinline__ void xcd_barrier_complete(unsigned* bar, unsigned x, unsigned& nloc, unsigned& nx) {
    const unsigned G = gridDim.x * gridDim.y * gridDim.z;
    unsigned sum, cnt, mine, sp = 0u;
    for (;;) {
        sum = 0u; cnt = 0u; mine = 0u;
#pragma unroll
        for (unsigned j = 0; j < 16; ++j) { const unsigned c = xb_ld(&bar[XB_XCNT(j)]); sum += c; cnt += (c > 0u) ? 1u : 0u; mine = (j == x) ? c : mine; }
        if (sum == G) break;
        __builtin_amdgcn_s_sleep(1);
        if ((++sp & 255u) == 0u) { if (xb_ld(&bar[XB_TMO])) break; if (sp > XB_SPIN_CAP) { atomicAdd(&bar[XB_TMO], 1u); break; } }
    }
    nloc = mine > 0u ? mine : 1u; nx = cnt > 0u ? cnt : 1u;
}
__device__ __forceinline__ void xcd_barrier(const XcdBarrier& b) {
    asm volatile("s_waitcnt vmcnt(0)" ::: "memory");
    __syncthreads();
    if (threadIdx.x == 0) {
        unsigned* bar = b.bar;
        __builtin_amdgcn_s_waitcnt(0);
        unsigned nloc = b.st[0], nx = b.st[1];
        if (nloc == 0u) { xcd_barrier_complete(bar, b.x, nloc, nx); b.st[0] = nloc; b.st[1] = nx; }
        const unsigned old = xb_add(&bar[XB_XSUB(b.x)], 1u);
        const unsigned gen = old / nloc;
        if (old + 1u == (gen + 1u) * nloc) {
            __builtin_amdgcn_fence(__ATOMIC_RELEASE, "agent");
            asm volatile("s_waitcnt vmcnt(0)" ::: "memory");
            const unsigned og = xb_add(&bar[XB_TOP], 1u);
            const unsigned tg = og / nx;
            if (og + 1u == (tg + 1u) * nx) xb_add(&bar[XB_TOPGEN], 1u);
            else XB_SPIN(xb_ld(&bar[XB_TOPGEN]) == tg, bar);
            __builtin_amdgcn_fence(__ATOMIC_ACQUIRE, "agent");
            xb_add(&bar[XB_XGEN(b.x)], 1u);
            asm volatile("s_waitcnt vmcnt(0)" ::: "memory");
        } else {
            XB_SPIN(xb_ld(&bar[XB_XGEN(b.x)]) == gen, bar);
            __builtin_amdgcn_fence(__ATOMIC_ACQUIRE, "agent");
            asm volatile("s_waitcnt vmcnt(0)" ::: "memory");
        }
    }
    __syncthreads();
}

namespace pg {
constexpr int BM = 256, BK = 64, HALF = 128, HTB = HALF * BK * 2, STAGE_BYTES = 8 * HTB, NXCD = 8, WGM = 8;
__host__ __device__ __forceinline__ int lds_byte(int r, int c) { const int st = (r >> 4) * 2 + (c >> 5), rr = r & 15, cc = c & 31, ob = rr * 64 + cc * 2; return st * 1024 + (ob ^ (((ob >> 9) & 1) << 5)); }
__host__ __device__ __forceinline__ void stage_rc(int b, int& R, int& C) { const int st = b / 1024, sb = b % 1024, swz = sb ^ (((sb >> 9) & 1) << 5); R = (st >> 1) * 16 + swz / 64; C = (st & 1) * 32 + (swz % 64) / 2; }
__host__ __device__ __forceinline__ int perm32(int rho) { const int n = rho >> 4, i = rho & 15; return 8 * (i >> 2) + 4 * n + (i & 3); }

struct Unit { int pm, pn; long boff; int koff; };

struct StaticOrder {
    int nM, nN, nwg, G, c;
    __device__ __forceinline__ void init(int M, int N, int G_, int c_) { nM = M / BM; nN = N / BM; nwg = nM * nN; G = G_; c = c_; }
    __device__ __forceinline__ bool next(int i, Unit& u) const {
        const long L = (long)i * G + c; if (L >= nwg) return false;
        int wgid = (int)L; { const int q = nwg / NXCD, r = nwg % NXCD, xcd = wgid % NXCD, off = wgid / NXCD; wgid = (xcd < r ? xcd * (q + 1) : r * (q + 1) + (xcd - r) * q) + off; }
        const int nig = WGM * nN, gid = wgid / nig, fm = gid * WGM, gsz = (nM - fm) < WGM ? (nM - fm) : WGM;
        u.pm = fm + ((wgid % nig) % gsz); u.pn = (wgid % nig) / gsz; u.boff = 0; u.koff = 0; return true;
    }
};
template <int NN, int KSPLIT, long ESTRIDE>
struct MoeOrder {
    static constexpr int nN = NN, ksplit = KSPLIT; static constexpr long estride = ESTRIDE;
    int t0, t1, G, c, klen; int base[NEXP + 1];
    int rd_ntc = 0, rd_R = 1 << 20;
    __device__ __forceinline__ bool next(int i, Unit& u) const {
        const int late = i - rd_R > 0 ? i - rd_R : 0;
        const int L = i * G + c - late * rd_ntc, nwg = (t1 - t0) * nN * ksplit;
        if (L >= nwg || (late > 0 && c < rd_ntc)) return false;
        int ks, pm_, pn_;
        if (ksplit == 1) {
            int wgid = (int)L; { const int q = nwg / NXCD, r = nwg % NXCD, xcd = wgid % NXCD, off = wgid / NXCD; wgid = (xcd < r ? xcd * (q + 1) : r * (q + 1) + (xcd - r) * q) + off; }
            const int nT_ = t1 - t0, nig = WGM * nN, gid = wgid / nig, fm = gid * WGM, gsz = (nT_ - fm) < WGM ? (nT_ - fm) : WGM;
            pm_ = fm + ((wgid % nig) % gsz); pn_ = (wgid % nig) / gsz; ks = 0;
        } else { ks = (int)(L % ksplit); const int r = (int)(L / ksplit); pm_ = r / nN; pn_ = r % nN; }
        u.pm = t0 + pm_; u.pn = pn_; u.koff = ks * klen;
        int e = 0;
#pragma unroll
        for (int k = 1; k < NEXP; ++k) if (u.pm * BM >= base[k]) e = k;
        u.boff = (long)e * estride; return true;
    }
};

typedef f32x4 Acc[2][2][4][2];
typedef float f32x32 __attribute__((ext_vector_type(32)));
typedef f32x32 Acc32[2][2];
__device__ __forceinline__ f32x4 acc4(const Acc& a, int ai, int bj, int m, int n) { return a[ai][bj][m][n]; }
__device__ __forceinline__ f32x4 acc4(const Acc32& a, int ai, int bj, int m, int n) { const int e = (m * 2 + n) * 4; return (f32x4){a[ai][bj][e], a[ai][bj][e + 1], a[ai][bj][e + 2], a[ai][bj][e + 3]}; }

struct EpiQKV {
    static constexpr bool PERM = true;
    bf16_t* O; float scale_q;
    __device__ __forceinline__ void operator()(const Acc& acc, const Unit& u, int wr, int wc, int fr, int fq) const {
        const int gp = u.pn >> 1, g = gp / 3, dsh = 2 * g, hb = (u.pn & 1) * 4;
        const float sc = (gp - 3 * g) == 0 ? scale_q : 1.f;
        const int row0 = u.pm * BM + wr * 64 + fr, d0 = (wc & 1) * 32 + 8 * fq;
#pragma unroll
        for (int ai = 0; ai < 2; ++ai)
#pragma unroll
            for (int m = 0; m < 4; ++m) { const int r = row0 + ai * HALF + m * 16, t = r & (SEQ - 1);
                const size_t rp = (size_t)(r - t) + ((size_t)(t & ((1 << dsh) - 1)) << (14 - dsh)) + (t >> dsh);
#pragma unroll
                for (int bj = 0; bj < 2; ++bj) { const f32x4 v0 = acc[ai][bj][m][0] * sc, v1 = acc[ai][bj][m][1] * sc;
                    u32x4 w; w.x = pk2(v0[0], v0[1]); w.y = pk2(v0[2], v0[3]); w.z = pk2(v1[0], v1[1]); w.w = pk2(v1[2], v1[3]);
                    *(u32x4*)(O + ((size_t)(gp * 8 + hb + 2 * bj + (wc >> 1)) * T + rp) * 64 + d0) = w; } }
    }
};
static_assert(SEQ == (1 << 14), "residue-major row arithmetic assumes SEQ = 2^14");
__device__ __forceinline__ float quad_col_sum(float s) {
    s += __builtin_bit_cast(float, __builtin_amdgcn_ds_swizzle(__builtin_bit_cast(int, s), 0x401F));
    return s + __builtin_bit_cast(float, __builtin_amdgcn_ds_bpermute((int)((threadIdx.x ^ 32u) << 2), __builtin_bit_cast(int, s)));
}
template <bool F32RES, bool F32OUT>
struct EpiResBf {
    static constexpr bool PERM = true;
    const void* res; float* out; bf16_t* xb; float* ssq;
    __device__ __forceinline__ void operator()(const Acc& acc, const Unit& u, int wr, int wc, int fr, int fq) const {
        const int col0 = u.pn * BM + wc * 32 + 8 * fq;
#pragma unroll
        for (int ai = 0; ai < 2; ++ai)
#pragma unroll
            for (int m = 0; m < 4; ++m) { const int row = u.pm * BM + ai * HALF + wr * 64 + m * 16 + fr; const size_t off = (size_t)row * DM + col0; float sq = 0.f;
#pragma unroll
                for (int bj = 0; bj < 2; ++bj) {
                    f32x4 v0, v1;
                    if (F32RES) { v0 = *(const f32x4*)((const float*)res + off + bj * HALF); v1 = *(const f32x4*)((const float*)res + off + bj * HALF + 4); }
                    else { const u32x4 rw = *(const u32x4*)((const bf16_t*)res + off + bj * HALF); v0 = (f32x4){bflo(rw.x), bfhi(rw.x), bflo(rw.y), bfhi(rw.y)}; v1 = (f32x4){bflo(rw.z), bfhi(rw.z), bflo(rw.w), bfhi(rw.w)}; }
                    v0 = v0 + acc[ai][bj][m][0]; v1 = v1 + acc[ai][bj][m][1];
                    if (F32OUT) { *(f32x4*)(out + off + bj * HALF) = v0; *(f32x4*)(out + off + bj * HALF + 4) = v1; }
                    sq += (v0[0] * v0[0] + v0[1] * v0[1]) + (v0[2] * v0[2] + v0[3] * v0[3]) + (v1[0] * v1[0] + v1[1] * v1[1]) + (v1[2] * v1[2] + v1[3] * v1[3]);
                    u32x4 w; w.x = pk2(v0[0], v0[1]); w.y = pk2(v0[2], v0[3]); w.z = pk2(v1[0], v1[1]); w.w = pk2(v1[2], v1[3]);
                    *(u32x4*)(xb + off + bj * HALF) = w; }
                sq = quad_col_sum(sq);
                if (fq == 0) ssq[(size_t)row * 16 + 4 * u.pn + wc] = sq; }
    }
};
__device__ __forceinline__ float row_rrms(const float* ssq, int row) {
    const f32x4* p = (const f32x4*)(ssq + (size_t)row * 16); const f32x4 a = p[0], b = p[1], c = p[2], d = p[3];
    const float t = (((a[0] + a[1]) + (a[2] + a[3])) + ((b[0] + b[1]) + (b[2] + b[3]))) + (((c[0] + c[1]) + (c[2] + c[3])) + ((d[0] + d[1]) + (d[2] + d[3])));
    return __builtin_amdgcn_rsqf(t * (1.f / DM) + RMS_EPS);
}
template <int Q0, int NQ>
__device__ __forceinline__ float slot_rrms(const float* ssl, int row, float inv_n) {
    const f32x4* p = (const f32x4*)(ssl + (size_t)row * 32) + Q0; float t = 0.f;
#pragma unroll
    for (int q = 0; q < NQ; ++q) { const f32x4 a = p[q]; t += (a[0] + a[1]) + (a[2] + a[3]); }
    return __builtin_amdgcn_rsqf(t * inv_n + RMS_EPS);
}
struct EpiLat {
    static constexpr bool PERM = true;
    bf16_t* cq; bf16_t* ckv; bf16_t* kr; const float* ssq; float* ssl; const float* cs; const float* sn;
    __device__ __forceinline__ void operator()(const Acc& acc, const Unit& u, int wr, int wc, int fr, int fq) const {
        const int row0 = u.pm * BM + wr * 64 + fr;
#pragma unroll
        for (int ai = 0; ai < 2; ++ai)
#pragma unroll
            for (int m = 0; m < 4; ++m) { const int row = row0 + ai * HALF + m * 16; const float sc = row_rrms(ssq, row);
#pragma unroll
                for (int bj = 0; bj < 2; ++bj) { const int cb = u.pn * BM + bj * HALF;
                    const f32x4 v0 = acc[ai][bj][m][0] * sc, v1 = acc[ai][bj][m][1] * sc;
                    if (cb < QL + KVL) {
                        u32x4 w; w.x = pk2(v0[0], v0[1]); w.y = pk2(v0[2], v0[3]); w.z = pk2(v1[0], v1[1]); w.w = pk2(v1[2], v1[3]);
                        bf16_t* dst = cb < QL ? cq + (size_t)row * QL + cb : ckv + (size_t)row * KVL + (cb - QL);
                        *(u32x4*)(dst + wc * 32 + 8 * fq) = w;
                        float sq = (v0[0] * v0[0] + v0[1] * v0[1]) + (v0[2] * v0[2] + v0[3] * v0[3]) + (v1[0] * v1[0] + v1[1] * v1[1]) + (v1[2] * v1[2] + v1[3] * v1[3]);
                        sq = quad_col_sum(sq);
                        if (fq == 0) ssl[(size_t)row * 32 + (cb >> 7) * 4 + wc] = sq;
                    } else if (cb == QL + KVL && wc == 0) {
                        const f32x4 c = *(const f32x4*)(cs + (size_t)row * 16 + 4 * fq), s_ = *(const f32x4*)(sn + (size_t)row * 16 + 4 * fq);
                        u32x4 w; w.x = pk2(v0[0] * c[0] - v0[1] * s_[0], v0[0] * s_[0] + v0[1] * c[0]); w.y = pk2(v0[2] * c[1] - v0[3] * s_[1], v0[2] * s_[1] + v0[3] * c[1]);
                        w.z = pk2(v1[0] * c[2] - v1[1] * s_[2], v1[0] * s_[2] + v1[1] * c[2]); w.w = pk2(v1[2] * c[3] - v1[3] * s_[3], v1[2] * s_[3] + v1[3] * c[3]);
                        *(u32x4*)(kr + (size_t)row * 32 + 8 * fq) = w; } } }
    }
};
struct EpiKVScale {
    static constexpr bool PERM = true;
    bf16_t* O; int ldc; const float* ssl;
    __device__ __forceinline__ void operator()(const Acc& acc, const Unit& u, int wr, int wc, int fr, int fq) const {
        const int row0 = u.pm * BM + wr * 64 + fr, col0 = u.pn * BM + wc * 32 + 8 * fq;
#pragma unroll
        for (int ai = 0; ai < 2; ++ai)
#pragma unroll
            for (int m = 0; m < 4; ++m) { const int row = row0 + ai * HALF + m * 16; const float sc = slot_rrms<3, 2>(ssl, row, 1.f / KVL); bf16_t* rowp = O + (size_t)row * ldc + col0;
#pragma unroll
                for (int bj = 0; bj < 2; ++bj) { const f32x4 v0 = acc[ai][bj][m][0] * sc, v1 = acc[ai][bj][m][1] * sc;
                    u32x4 w; w.x = pk2(v0[0], v0[1]); w.y = pk2(v0[2], v0[3]); w.z = pk2(v1[0], v1[1]); w.w = pk2(v1[2], v1[3]);
                    *(u32x4*)(rowp + bj * HALF) = w; } }
    }
};
template <int RS, bool OUT8 = false>
struct EpiSwiGLUT {
    static constexpr bool PERM = true;
    bf16_t* O; int ldc; const float* rs;
    template <class AccT>
    __device__ __forceinline__ void operator()(const AccT& acc, const Unit& u, int wr, int wc, int fr, int fq) const {
        const int row0 = u.pm * BM + wr * 64 + fr, col0 = u.pn * HALF + wc * 32 + 8 * fq;
        float rrv[8];
#pragma unroll
        for (int i = 0; i < 8; ++i) rrv[i] = RS ? rs[row0 + (i >> 2) * HALF + (i & 3) * 16] : 1.f;
        if (RS) __builtin_amdgcn_sched_barrier(0);
#pragma unroll
        for (int ai = 0; ai < 2; ++ai)
#pragma unroll
            for (int m = 0; m < 4; ++m) { float o[8]; const float rr = rrv[ai * 4 + m];
                const float c1 = -rr * LOG2E, kk = fast_rcp(rr * rr * (OUT8 ? 8.f : 1.f));
#pragma unroll
                for (int n = 0; n < 2; ++n) { const f32x4 ag = acc4(acc, ai, 0, m, n), au = acc4(acc, ai, 1, m, n);
#pragma unroll
                    for (int j = 0; j < 4; ++j) o[4 * n + j] = (ag[j] * au[j]) * fast_rcp(__builtin_fmaf(fast_exp2(ag[j] * c1), kk, kk)); }
                if (OUT8) { u32x2 w8; w8.x = pk4_fp8(o[0], o[1], o[2], o[3]); w8.y = pk4_fp8(o[4], o[5], o[6], o[7]);
                    *(u32x2*)((unsigned char*)O + (size_t)(row0 + ai * HALF + m * 16) * ldc + col0) = w8; }
                else { u32x4 w; w.x = pk2(o[0], o[1]); w.y = pk2(o[2], o[3]); w.z = pk2(o[4], o[5]); w.w = pk2(o[6], o[7]);
                    *(u32x4*)(O + (size_t)(row0 + ai * HALF + m * 16) * ldc + col0) = w; } }
    }
};
typedef EpiSwiGLUT<1, true> EpiSwiGLU;
struct EpiQRope {
    static constexpr bool PERM = true;
    bf16_t* O; const float* cs; const float* sn; const float* ssl;
    __device__ __forceinline__ void operator()(const Acc& acc, const Unit& u, int wr, int wc, int fr, int fq) const {
        const int row0 = u.pm * BM + wr * 64 + fr;
#pragma unroll
        for (int ai = 0; ai < 2; ++ai)
#pragma unroll
            for (int m = 0; m < 4; ++m) { const int row = row0 + ai * HALF + m * 16; const float qs = C2_MLA * slot_rrms<0, 3>(ssl, row, 1.f / QL);
#pragma unroll
                for (int bj = 0; bj < 2; ++bj) { const int c0 = u.pn * BM + bj * HALF + wc * 32 + 8 * fq; const int cc = c0 % HQ;
                    f32x4 v0 = acc[ai][bj][m][0], v1 = acc[ai][bj][m][1];
                    if (cc >= 64) { const int i0 = (cc - 64) >> 1;
                        const f32x4 c = *(const f32x4*)(cs + (size_t)row * 16 + i0), s = *(const f32x4*)(sn + (size_t)row * 16 + i0);
                        const f32x4 a = v0, b = v1;
                        v0[0] = a[0] * c[0] - a[1] * s[0]; v0[1] = a[0] * s[0] + a[1] * c[0]; v0[2] = a[2] * c[1] - a[3] * s[1]; v0[3] = a[2] * s[1] + a[3] * c[1];
                        v1[0] = b[0] * c[2] - b[1] * s[2]; v1[1] = b[0] * s[2] + b[1] * c[2]; v1[2] = b[2] * c[3] - b[3] * s[3]; v1[3] = b[2] * s[3] + b[3] * c[3]; }
                    v0 = v0 * qs; v1 = v1 * qs;
                    u32x4 w; w.x = pk2(v0[0], v0[1]); w.y = pk2(v0[2], v0[3]); w.z = pk2(v1[0], v1[1]); w.w = pk2(v1[2], v1[3]);
                    *(u32x4*)(O + (size_t)row * QC + c0) = w; } }
    }
};
struct EpiMoeDown {
    static constexpr bool PERM = false;
    bf16_t* xb; const int* list; const float* gws;
    template <class AccT>
    __device__ __forceinline__ void operator()(const AccT& acc, const Unit& u, int wr, int wc, int fr, int fq) const {
        const int col0 = u.pn * BM + wc * 32 + 4 * fq;
#pragma unroll
        for (int ai = 0; ai < 2; ++ai)
#pragma unroll
            for (int m = 0; m < 4; ++m) { const int r = u.pm * BM + ai * HALF + wr * 64 + m * 16 + fr; const int tok = list[r]; const float w = gws[r];
                if (tok >= 0) { bf16_t* p = xb + (size_t)tok * DM + col0;
#pragma unroll
                    for (int bj = 0; bj < 2; ++bj)
#pragma unroll
                        for (int n = 0; n < 2; ++n) { const u32x2 bw = *(const u32x2*)(p + bj * HALF + n * 16);
                            const f32x4 v = (f32x4){bflo(bw.x), bfhi(bw.x), bflo(bw.y), bfhi(bw.y)} + acc4(acc, ai, bj, m, n) * w;
                            u32x2 o; o.x = pk2(v[0], v[1]); o.y = pk2(v[2], v[3]); *(u32x2*)(p + bj * HALF + n * 16) = o; } } }
    }
};

struct EpiMoeDownAtomic {
    static constexpr bool PERM = false;
    float* out; const int* list; const float* gws;
    template <class AccT>
    __device__ __forceinline__ void operator()(const AccT& acc, const Unit& u, int wr, int wc, int fr, int fq) const {
        const int col0 = u.pn * BM + wc * 32 + 4 * fq;
#pragma unroll
        for (int ai = 0; ai < 2; ++ai)
#pragma unroll
            for (int m = 0; m < 4; ++m) { const int r = u.pm * BM + ai * HALF + wr * 64 + m * 16 + fr; const int tok = list[r]; const float w = gws[r];
                if (tok >= 0) { float* p = out + (size_t)tok * DM + col0;
#pragma unroll
                    for (int bj = 0; bj < 2; ++bj)
#pragma unroll
                        for (int n = 0; n < 2; ++n) { const f32x4 av = acc4(acc, ai, bj, m, n);
#pragma unroll
                            for (int j = 0; j < 4; ++j) (void)__hip_atomic_fetch_add(p + bj * HALF + n * 16 + j, av[j] * w, __ATOMIC_RELAXED, __HIP_MEMORY_SCOPE_AGENT); } } }
    }
};

typedef int v8i32_t __attribute__((ext_vector_type(8)));
typedef int v4i32_t __attribute__((ext_vector_type(4)));
template <bool C, class A_, class B_> struct Sel { typedef A_ type; };
template <class A_, class B_> struct Sel<false, A_, B_> { typedef B_ type; };
template <class Epi, class Sched, bool GATHER, bool FP8 = false, int SCALE_A = 127, int SCALE_B = 127>
__device__ __forceinline__ void gemm_phase(LAS unsigned char* lds, const bf16_t* A, const bf16_t* Bt, const int Kc, const int ldc_, const int* list, const Sched& S, const Epi& E) {
    int K = Kc; asm volatile("" : "+s"(K));
    int LD = ldc_; asm volatile("" : "+s"(LD));
    int tid = threadIdx.x; asm volatile("" : "+v"(tid));
    const int wid = __builtin_amdgcn_readfirstlane(tid >> 6), lane = tid & 63, wr = wid >> 2, wc = wid & 3, fr = lane & 15, fq = lane >> 4;
    const int nt = K / BK;
    unsigned voffA[2], voffB[2];
#pragma unroll
    for (int i = 0; i < 2; ++i) { int R, C; stage_rc(tid * 16 + i * 8192, R, C); const int Rb = Epi::PERM ? ((R & ~31) + perm32(R & 31)) : R; voffA[i] = (unsigned)(R * LD + C) * 2u; voffB[i] = (unsigned)(Rb * LD + C) * 2u; }
    const size_t kstep = (size_t)(BK * 2);
    const size_t hstep = (size_t)HALF * LD * 2;
    const size_t tstep = 2 * hstep;
    const unsigned ldsw = (unsigned)wid * 1024u;
    const int aoff = lds_byte(wr * 64 + fr, fq * 8), boff = lds_byte(wc * 32 + fr, fq * 8);
    const char* A8 = (const char*)A;
#define PG_SA(b, h) (((b) * 2 + (h)) * HTB)
#define PG_SB(b, h) ((4 + (b) * 2 + (h)) * HTB)
#define PG_GLDS(src, bufoff, i_) __builtin_amdgcn_global_load_lds((const unsigned*)(src), (LAS unsigned*)(lds + (bufoff) + ldsw + (i_) * 8192), 16, 0, 0)
#define PG_STAGE_B(bufoff, gbase) do { _Pragma("unroll") for (int _i = 0; _i < 2; ++_i) PG_GLDS((const char*)(gbase) + voffB[_i], bufoff, _i); } while (0)
#define PG_STAGE_A(bufoff, CUR, h, kb) do { _Pragma("unroll") for (int _i = 0; _i < 2; ++_i) { \
        if constexpr (GATHER) PG_GLDS(((CUR) ? cA : nA) + (kb) + ((CUR) ? vaC[h][_i] : vaN[h][_i]), bufoff, _i); \
        else PG_GLDS(((CUR) ? cA : nA) + (size_t)(h) * hstep + (kb) + voffA[_i], bufoff, _i); } } while (0)
#define PG_LD1(D_, ADDR_) do { if constexpr (FP8) { const v4i32_t lo_ = *(const LAS v4i32_t*)(ADDR_), hi_ = *(const LAS v4i32_t*)((ADDR_) + 1024); D_ = __builtin_shufflevector(lo_, hi_, 0, 1, 2, 3, 4, 5, 6, 7); } \
        else { D_[0] = *(const LAS bf16x8*)(ADDR_); D_[1] = *(const LAS bf16x8*)((ADDR_) + 1024); } } while (0)
#define PG_LDA(dst, b, h) do { _Pragma("unroll") for (int m = 0; m < 4; ++m) PG_LD1(dst[m], lds + PG_SA(b, h) + aoff + m * 2048); } while (0)
#define PG_LDB(dst, b, h) do { _Pragma("unroll") for (int n = 0; n < 2; ++n) PG_LD1(dst[n], lds + PG_SB(b, h) + boff + n * 2048); } while (0)
#define PG_MMA(ai, bj, At, Bq) do { __builtin_amdgcn_s_setprio(1); _Pragma("unroll") for (int m = 0; m < 4; ++m) _Pragma("unroll") for (int n = 0; n < 2; ++n) { \
        if constexpr (FP8) { f32x4 c_; _Pragma("unroll") for (int j_ = 0; j_ < 4; ++j_) c_[j_] = acc[ai][bj][(m * 2 + n) * 4 + j_]; \
            asm volatile("v_mfma_f32_16x16x128_f8f6f4 %0, %1, %2, %0" : "+v"(c_) : "v"(Bq[n]), "v"(At[m])); \
            _Pragma("unroll") for (int j_ = 0; j_ < 4; ++j_) acc[ai][bj][(m * 2 + n) * 4 + j_] = c_[j_]; } \
        else { _Pragma("unroll") for (int k = 0; k < 2; ++k) acc[ai][bj][m][n] = __builtin_amdgcn_mfma_f32_16x16x32_bf16(Bq[n][k], At[m][k], acc[ai][bj][m][n], 0, 0, 0); } } \
        __builtin_amdgcn_s_setprio(0); } while (0)
#define PG_WAIT_V(n) asm volatile("s_waitcnt vmcnt(" #n ")" ::: "memory")
#define PG_WAIT_L(n) asm volatile("s_waitcnt lgkmcnt(" #n ")" ::: "memory")
#define PG_BAR __builtin_amdgcn_s_barrier()
#define PG_SCHED __builtin_amdgcn_sched_barrier(0)
#define PG_LOAD_VA(dst, U) do { _Pragma("unroll") for (int _h = 0; _h < 2; ++_h) _Pragma("unroll") for (int _i = 0; _i < 2; ++_i) { int _R, _C; stage_rc(tid * 16 + _i * 8192, _R, _C); \
        int _r = list[(U).pm * BM + _h * HALF + _R]; _r = _r < 0 ? 0 : _r; dst[_h][_i] = (unsigned)_r * (unsigned)(LD * 2) + (unsigned)(_C * 2); } } while (0)
    Unit cur, nxt; int ui = 0;
    if (!S.next(0, cur)) return;
    typename Sel<FP8, Acc32, Acc>::type acc;
#define PG_ZERO_ACC() do { _Pragma("unroll") for (int a = 0; a < 2; ++a) _Pragma("unroll") for (int b = 0; b < 2; ++b) { \
        if constexpr (FP8) { _Pragma("unroll") for (int e_ = 0; e_ < 32; ++e_) acc[a][b][e_] = 0.f; } \
        else { _Pragma("unroll") for (int m = 0; m < 4; ++m) _Pragma("unroll") for (int n = 0; n < 2; ++n) acc[a][b][m][n] = (f32x4){0.f, 0.f, 0.f, 0.f}; } } } while (0)
    PG_ZERO_ACC();
    typename Sel<FP8, v8i32_t[4], bf16x8[4][2]>::type At; typename Sel<FP8, v8i32_t[2], bf16x8[2][2]>::type B0, B1;
    unsigned vaC[2][2], vaN[2][2];
    if constexpr (GATHER) { PG_LOAD_VA(vaC, cur); }
    const char* cA = A8 + (GATHER ? 0 : (size_t)cur.pm * tstep) + (size_t)cur.koff * 2; const char* nA = cA;
    const char* cB = (const char*)(Bt + cur.boff + cur.koff) + (size_t)cur.pn * tstep;
    PG_STAGE_B(PG_SB(0, 0), cB); PG_STAGE_B(PG_SB(0, 1), cB + hstep); PG_STAGE_A(PG_SA(0, 0), true, 0, 0); PG_STAGE_A(PG_SA(0, 1), true, 1, 0);
    if (wr == 1) PG_BAR;
    PG_WAIT_V(2); PG_BAR;
    PG_STAGE_B(PG_SB(1, 0), cB + kstep); PG_STAGE_A(PG_SA(1, 0), true, 0, kstep); PG_STAGE_B(PG_SB(1, 1), cB + hstep + kstep);
    PG_WAIT_V(6); PG_BAR;
    for (;;) {
        const bool has_next = S.next(ui + 1, nxt);
        const char* nB = has_next ? (const char*)(Bt + nxt.boff + nxt.koff) + (size_t)nxt.pn * tstep : cB;
        nA = has_next ? A8 + (GATHER ? 0 : (size_t)nxt.pm * tstep) + (size_t)nxt.koff * 2 : cA;
        if constexpr (GATHER) {
            if (has_next) { PG_LOAD_VA(vaN, nxt); }
            else {
#pragma unroll
                for (int h = 0; h < 2; ++h)
#pragma unroll
                    for (int i = 0; i < 2; ++i) vaN[h][i] = vaC[h][i]; }
        }
        for (int t = 0; t < nt; t += 2) {
            const bool last = (t == nt - 2);
            const size_t a1k = (size_t)(t + 1) * kstep;
            const size_t a2k = last ? 0 : (size_t)(t + 2) * kstep; const size_t a3k = a2k + kstep;
            const char* b2 = last ? nB : cB + (size_t)(t + 2) * kstep; const char* b3 = b2 + kstep;
            PG_LDB(B0, 0, 0); PG_LDB(B1, 0, 1); PG_SCHED; PG_LDA(At, 0, 0); PG_STAGE_A(PG_SA(1, 1), true, 1, a1k);
            PG_WAIT_V(8); PG_WAIT_L(0); PG_BAR; PG_MMA(0, 0, At, B0); PG_MMA(0, 1, At, B1); PG_BAR; PG_SCHED;
            PG_LDA(At, 0, 1); PG_STAGE_B(PG_SB(0, 0), b2); PG_STAGE_B(PG_SB(0, 1), b2 + hstep); PG_STAGE_A(PG_SA(0, 0), !last, 0, a2k);
            PG_WAIT_V(8); PG_WAIT_L(0); PG_BAR; PG_MMA(1, 0, At, B0); PG_MMA(1, 1, At, B1); PG_BAR; PG_SCHED;
            PG_LDB(B0, 1, 0); PG_LDB(B1, 1, 1); PG_SCHED; PG_LDA(At, 1, 0); PG_STAGE_A(PG_SA(0, 1), !last, 1, a2k);
            PG_WAIT_V(8); PG_WAIT_L(0); PG_BAR; PG_MMA(0, 0, At, B0); PG_MMA(0, 1, At, B1); PG_BAR; PG_SCHED;
            PG_LDA(At, 1, 1); PG_STAGE_B(PG_SB(1, 0), b3); PG_STAGE_B(PG_SB(1, 1), b3 + hstep); PG_STAGE_A(PG_SA(1, 0), !last, 0, a3k);
            PG_WAIT_V(8); PG_WAIT_L(0); PG_BAR; PG_MMA(1, 0, At, B0); PG_MMA(1, 1, At, B1); PG_BAR; PG_SCHED;
        }
        if (wr == 0) PG_BAR;
        if constexpr (FP8) asm volatile("s_nop 15\n\ts_nop 15" ::: "memory");
        E(acc, cur, wr, wc, fr, fq);
        if (!has_next) break;
        PG_ZERO_ACC();
        cur = nxt; cB = nB; cA = nA; ++ui;
        if constexpr (GATHER) {
#pragma unroll
            for (int h = 0; h < 2; ++h)
#pragma unroll
                for (int i = 0; i < 2; ++i) vaC[h][i] = vaN[h][i]; }
        if (wr == 1) PG_BAR;
    }
    PG_WAIT_V(0);
    PG_BAR;
#undef PG_SA
#undef PG_SB
#undef PG_GLDS
#undef PG_STAGE_A
#undef PG_STAGE_B
#undef PG_LD1
#undef PG_ZERO_ACC
#undef PG_LDA
#undef PG_LDB
#undef PG_MMA
#undef PG_WAIT_V
#undef PG_WAIT_L
#undef PG_BAR
#undef PG_SCHED
#undef PG_LOAD_VA
}
}

namespace att {
typedef short v4i16_t __attribute__((ext_vector_type(4)));
__device__ __forceinline__ int crow(int r, int hi) { return (r & 3) + 8 * (r >> 2) + 4 * hi; }
#define ATT_WAIT_BAR(N) asm volatile("s_waitcnt vmcnt(" #N ") lgkmcnt(0)\n\ts_barrier" ::: "memory")
__device__ __forceinline__ void glds16(const void* gsrc, unsigned lds_dst) { unsigned keep;
    asm volatile("s_mov_b32 %0, m0\n\ts_mov_b32 m0, %2\n\ts_nop 0\n\tglobal_load_lds_dwordx4 %1, off\n\ts_mov_b32 m0, %0" : "=&s"(keep) : "v"(gsrc), "s"(lds_dst) : "memory"); }
__device__ __forceinline__ unsigned lds_addr(const LAS unsigned char* p) { return (unsigned)(uintptr_t)p; }
template <int NKS>
__device__ __forceinline__ void qkt(f32x16& p0, f32x16& p1, const LAS unsigned char* Kslot, const bf16x8 (&qr)[NKS], int r32, int hi) {
    const LAS unsigned char* kb = Kslot + hi * 1024 + r32 * 16;
    f32x16 z;
#pragma unroll
    for (int r = 0; r < 16; ++r) z[r] = 0.f;
    p0 = z; p1 = z;
#pragma unroll
    for (int d0 = 0; d0 < NKS; ++d0) {
        const bf16x8 b0 = *(const LAS bf16x8*)(kb + d0 * 2048);
        const bf16x8 b1 = *(const LAS bf16x8*)(kb + d0 * 2048 + 512);
        p0 = __builtin_amdgcn_mfma_f32_32x32x16_bf16(b0, qr[d0], p0, 0, 0, 0);
        p1 = __builtin_amdgcn_mfma_f32_32x32x16_bf16(b1, qr[d0], p1, 0, 0, 0);
    }
}
__device__ __forceinline__ void softmax_step(f32x16& p0, f32x16& p1, float& m_run, float& l_run, f32x16 (&o)[2], LAS float* wsf, int r32, int hi) {
    float rm = fmaxf(p0[0], p1[0]);
#pragma unroll
    for (int r = 1; r < 16; ++r) rm = fmaxf(rm, fmaxf(p0[r], p1[r]));
    { auto rr = __builtin_amdgcn_permlane32_swap(__float_as_uint(rm), __float_as_uint(rm), false, false); rm = fmaxf(__uint_as_float(rr[0]), __uint_as_float(rr[1])); }
    const float m_new = fmaxf(m_run, rm);
    const float alpha = fast_exp2(m_run - m_new);
    float s = 0.f;
#pragma unroll
    for (int r = 0; r < 16; ++r) { p0[r] = fast_exp2(p0[r] - m_new); p1[r] = fast_exp2(p1[r] - m_new); s += p0[r] + p1[r]; }
    l_run = l_run * alpha + s;
    const bool need = __any(m_new > m_run);
    m_run = m_new;
    if (need) {
        if (hi == 0) wsf[r32] = alpha;
        LDS_WAIT();
#pragma unroll
        for (int r = 0; r < 16; ++r) { const float f = wsf[crow(r, hi)]; o[0][r] *= f; o[1][r] *= f; }
        LDS_WAIT();
    }
}
__device__ __forceinline__ void pv_step(f32x16 (&o)[2], const f32x16& p0, const f32x16& p1, const LAS unsigned char* Vslot, int lane, int hi) {
    u32x4 pw[4];
    pw[0] = (u32x4){pk2(p0[0], p0[1]), pk2(p0[2], p0[3]), pk2(p0[4], p0[5]), pk2(p0[6], p0[7])};
    pw[1] = (u32x4){pk2(p0[8], p0[9]), pk2(p0[10], p0[11]), pk2(p0[12], p0[13]), pk2(p0[14], p0[15])};
    pw[2] = (u32x4){pk2(p1[0], p1[1]), pk2(p1[2], p1[3]), pk2(p1[4], p1[5]), pk2(p1[6], p1[7])};
    pw[3] = (u32x4){pk2(p1[8], p1[9]), pk2(p1[10], p1[11]), pk2(p1[12], p1[13]), pk2(p1[14], p1[15])};
    const LAS unsigned char* vb = Vslot + ((lane >> 4) & 1) * 32 + (lane & 3) * 8 + (4 * hi + ((lane & 15) >> 2)) * 64;
#pragma unroll
    for (int d0 = 0; d0 < 2; ++d0)
#pragma unroll
        for (int ks = 0; ks < 4; ++ks) {
            const s16x4 lo = __builtin_bit_cast(s16x4, __builtin_amdgcn_ds_read_tr16_b64_v4i16((LAS v4i16_t*)(vb + d0 * 4096 + ks * 1024)));
            const s16x4 hh = __builtin_bit_cast(s16x4, __builtin_amdgcn_ds_read_tr16_b64_v4i16((LAS v4i16_t*)(vb + d0 * 4096 + ks * 1024 + 512)));
            const bf16x8 vf = (bf16x8){lo[0], lo[1], lo[2], lo[3], hh[0], hh[1], hh[2], hh[3]};
            o[d0] = __builtin_amdgcn_mfma_f32_32x32x16_bf16(__builtin_bit_cast(bf16x8, pw[ks]), vf, o[d0], 0, 0, 0);
        }
}
__device__ __forceinline__ float finish_rows(f32x16 (&o)[2], float l_run, LAS float* wsf, LAS bf16_t* stg, int r32, int hi) {
    const float l = l_run + __shfl_xor(l_run, 32);
    if (hi == 0) wsf[32 + r32] = l;
    LDS_WAIT();
#pragma unroll
    for (int r = 0; r < 16; ++r) { const int orow = crow(r, hi); const float rl = fast_rcp(wsf[32 + orow]);
#pragma unroll
        for (int d0 = 0; d0 < 2; ++d0) stg[orow * 64 + d0 * 32 + r32] = (bf16_t)f2bf(o[d0][r] * rl); }
    LDS_WAIT();
    return l;
}
}

struct Args { const void* in[20]; float* out; unsigned char* ws; };

struct Frame {
    LAS unsigned char* lds;
    int tid, lane, wave, G, bid;
};
__device__ __forceinline__ Frame phase_frame(const Frame& F) { Frame P = F; asm volatile("" : "+v"(P.tid)); P.lane = P.tid & 63; return P; }

__device__ __forceinline__ void tr_item(const float* __restrict__ W, int ldw, int k0, int scol, bf16_t* WT, int K, int drow0, LAS float* scr, int lane, const float* gain = nullptr) {
#pragma unroll 8
    for (int i = 0; i < 32; ++i) { const int kk = 2 * i + (lane >> 5); scr[kk * 33 + (lane & 31)] = scol >= 0 ? W[(size_t)(k0 + kk) * ldw + scol] * (gain ? gain[k0 + kk] : 1.f) : 0.f; }
    LDS_WAIT(); asm volatile("" ::: "memory");
    const int c = lane & 7;
#pragma unroll
    for (int j = 0; j < 4; ++j) { const int n = (lane >> 3) + 8 * j; const LAS float* s = scr + (8 * c) * 33 + n;
        u32x4 o; o.x = pk2(s[0 * 33], s[1 * 33]); o.y = pk2(s[2 * 33], s[3 * 33]); o.z = pk2(s[4 * 33], s[5 * 33]); o.w = pk2(s[6 * 33], s[7 * 33]);
        *(u32x4*)(WT + (size_t)(drow0 + n) * K + k0 + 8 * c) = o; }
    LDS_WAIT(); asm volatile("" ::: "memory");
}
template <bool GAIN = false, bool FP8 = false>
__device__ __forceinline__ void tr_item64(const float* __restrict__ W, int ldw, int k0, int scol0, bf16_t* WT, int K, int drow0, LAS unsigned char* scr, int lane, const float* gain = nullptr) {
    const int kr = lane >> 4, nq = lane & 15;
    const float* src = W + (size_t)(k0 + kr) * ldw + scol0 + 4 * nq;
    f32x4 v[16];
#pragma unroll
    for (int i = 0; i < 16; ++i) v[i] = __builtin_nontemporal_load((const f32x4*)(src + (size_t)(4 * i) * ldw));
    if (GAIN) {
#pragma unroll
        for (int i = 0; i < 16; ++i) v[i] = v[i] * gain[k0 + kr + 4 * i]; }
#pragma unroll
    for (int i = 0; i < 16; ++i) { u32x2 w; w.x = pk2(v[i].x, v[i].y); w.y = pk2(v[i].z, v[i].w); *(LAS u32x2*)(scr + (4 * i + kr) * 192 + nq * 8) = w; }
    LDS_WAIT(); asm volatile("" ::: "memory");
    const int g = lane >> 4;
    const LAS unsigned char* rb = scr + ((lane & 15) >> 2) * 192 + g * 32 + (lane & 3) * 8;
    bf16_t* dst = WT + (size_t)(drow0 + 16 * g + (lane & 15)) * K + k0;
    unsigned char* dst8 = (unsigned char*)WT + (size_t)(drow0 + 16 * g + (lane & 15)) * K + k0;
#pragma unroll
    for (int kc = 0; kc < 8; ++kc) {
        const s16x4 lo = __builtin_bit_cast(s16x4, __builtin_amdgcn_ds_read_tr16_b64_v4i16((LAS att::v4i16_t*)(rb + (8 * kc) * 192)));
        const s16x4 hh = __builtin_bit_cast(s16x4, __builtin_amdgcn_ds_read_tr16_b64_v4i16((LAS att::v4i16_t*)(rb + (8 * kc + 4) * 192)));
        if (FP8) { u32x2 w8;
            w8.x = pk4_fp8(bf2f((unsigned short)lo[0]) * 64.f, bf2f((unsigned short)lo[1]) * 64.f, bf2f((unsigned short)lo[2]) * 64.f, bf2f((unsigned short)lo[3]) * 64.f);
            w8.y = pk4_fp8(bf2f((unsigned short)hh[0]) * 64.f, bf2f((unsigned short)hh[1]) * 64.f, bf2f((unsigned short)hh[2]) * 64.f, bf2f((unsigned short)hh[3]) * 64.f);
            *(u32x2*)(dst8 + 8 * kc) = w8;
        } else *(bf16x8*)(dst + 8 * kc) = (bf16x8){lo[0], lo[1], lo[2], lo[3], hh[0], hh[1], hh[2], hh[3]};
    }
    LDS_WAIT(); asm volatile("" ::: "memory");
}
template <bool GAIN = false, bool FP8 = false>
__device__ __forceinline__ void tr_plain64(const float* W, int K, int N, bf16_t* WT, LAS unsigned char* scr, int item, int lane, const float* gain = nullptr) {
    const int nblk = N / 64, kb = item / nblk, nb = item % nblk;
    tr_item64<GAIN, FP8>(W, N, 64 * kb, 64 * nb, WT, K, 64 * nb, scr, lane, gain);
}
template <bool GAIN = false, bool FP8 = false>
__device__ __forceinline__ void tr_gateup64(const float* Wg, const float* Wu, int K, int F, bf16_t* WT, LAS unsigned char* scr, int item, int lane, const float* gain = nullptr) {
    const int nblk = (2 * F) / 64, kb = item / nblk, nb = item % nblk, n0 = 64 * nb, p = n0 >> 8, x = n0 & 255;
    tr_item64<GAIN, FP8>(x < 128 ? Wg : Wu, F, 64 * kb, 128 * p + (x & 127), WT, K, n0, scr, lane, gain);
}

__device__ __forceinline__ void load_gain(const float* g, f32x4 (&gv)[4], int lane) {
#pragma unroll
    for (int j = 0; j < 4; ++j) gv[j] = ((const f32x4*)g)[64 * j + lane];
}
__device__ __forceinline__ void norm_pass(const Frame& F, const float* x, const float* g, bf16_t* hn) {
    f32x4 gv[4]; load_gain(g, gv, F.lane);
    const int gw = F.bid * NWAVES + F.wave, NGW = F.G * NWAVES;
    f32x4 v[4], vn[4];
    if (gw < T) { const f32x4* xr = (const f32x4*)(x + (size_t)gw * DM) + F.lane;
#pragma unroll
        for (int j = 0; j < 4; ++j) v[j] = xr[64 * j]; }
    for (int m = gw; m < T; m += NGW) {
        const int mn = m + NGW < T ? m + NGW : m;
        { const f32x4* xr = (const f32x4*)(x + (size_t)mn * DM) + F.lane;
#pragma unroll
          for (int j = 0; j < 4; ++j) vn[j] = xr[64 * j]; }
        __builtin_amdgcn_sched_barrier(0);
        float s = 0.f;
#pragma unroll
        for (int j = 0; j < 4; ++j) s += (v[j].x * v[j].x + v[j].y * v[j].y) + (v[j].z * v[j].z + v[j].w * v[j].w);
        const float r = __builtin_amdgcn_rsqf(wave_sum(s) * (1.f / DM) + RMS_EPS);
        u32x2* o8 = (u32x2*)(hn + (size_t)m * DM) + F.lane;
#pragma unroll
        for (int j = 0; j < 4; ++j) { const f32x4 y = v[j] * r * gv[j]; u32x2 w; w.x = pk2(y.x, y.y); w.y = pk2(y.z, y.w); o8[64 * j] = w; }
#pragma unroll
        for (int j = 0; j < 4; ++j) v[j] = vn[j];
    }
}

__device__ __forceinline__ float max3f(float a, float b, float c) { float r; asm("v_max3_f32 %0, %1, %2, %3" : "=v"(r) : "v"(a), "v"(b), "v"(c)); return r; }
constexpr int DA_K = 0, DA_V = 49152, DA_POS = 98304, DA_WS = DA_POS + 2048, DA_OST = DA_WS + 2048, DA_END = DA_OST + 32768;
static_assert(DA_END <= MISC_OFF, "dilated attention LDS");
struct DilUnit { int h, g, dil, res, q0; size_t rowb, srow; };
__device__ __forceinline__ DilUnit dil_decode(int u) {
    DilUnit d; d.h = u & 7; int rest = u >> 3; const int blk64 = rest & 63; rest >>= 6; d.g = rest % 3; const int b = rest / 3;
    const int dsh = 2 * d.g; d.dil = 1 << dsh;
    const int bpr = 64 >> dsh;
    d.res = blk64 / bpr; d.q0 = (blk64 % bpr) * 256;
    d.rowb = (size_t)b * SEQ; d.srow = d.rowb + (size_t)d.res * (SEQ >> dsh); return d;
}
__device__ __forceinline__ void dilated_phase(const Frame& F, const bf16_t* qkv, const int* positions, bf16_t* o3, float* lse) {
    const int lane = F.lane, wid = F.wave, r32 = lane & 31, hi = lane >> 5, tid = F.tid;
    LAS unsigned char* lds = F.lds;
    LAS float* posf = (LAS float*)(lds + DA_POS);
    LAS float* wsf = (LAS float*)(lds + DA_WS) + wid * 64;
    LAS bf16_t* stg = (LAS bf16_t*)(lds + DA_OST) + wid * 2048;
    const unsigned ldsb = att::lds_addr(lds);
    constexpr int NUNITS = BATCH * 3 * 64 * 8;
    int u = F.bid;
    if (u >= NUNITS) return;
    DilUnit d = dil_decode(u);
#define DA_SLAB(D_, part_) (qkv + ((size_t)(((D_).g * 3 + (part_)) * 8 + (D_).h) * T + (D_).srow) * 64)
#define DA_DMA_K(D_) do { const bf16_t* kb_ = DA_SLAB(D_, 1) + wid * 8; _Pragma("unroll") for (int j_ = 0; j_ < 6; ++j_) { int kl_ = (D_).q0 - 128 + 64 * j_ + lane; kl_ = kl_ < 0 ? 0 : kl_; \
        att::glds16(kb_ + (size_t)kl_ * 64, (unsigned)__builtin_amdgcn_readfirstlane(ldsb + DA_K + j_ * 8192 + wid * 1024)); } } while (0)
#define DA_DMA_V(D_) do { const bf16_t* vb_ = DA_SLAB(D_, 2) + (wid >> 2) * 32 + (lane & 3) * 8; _Pragma("unroll") for (int j_ = 0; j_ < 6; ++j_) { int vl_ = (D_).q0 - 128 + 64 * j_ + 16 * (wid & 3) + (lane >> 2); vl_ = vl_ < 0 ? 0 : vl_; \
        att::glds16(vb_ + (size_t)vl_ * 64, (unsigned)__builtin_amdgcn_readfirstlane(ldsb + DA_V + j_ * 8192 + wid * 1024)); } } while (0)
#define DA_QLOAD(Q_, PQ_, D_) do { const int ql_ = (D_).q0 + 32 * wid + r32; const bf16_t* qp_ = DA_SLAB(D_, 0) + (size_t)ql_ * 64 + hi * 8; \
        _Pragma("unroll") for (int d0_ = 0; d0_ < 4; ++d0_) Q_[d0_] = *(const bf16x8*)(qp_ + d0_ * 16); PQ_ = positions[(D_).rowb + (size_t)ql_ * (D_).dil + (D_).res]; } while (0)
#define DA_POSLOAD(P_, D_) do { int kl_ = (D_).q0 - 128 + (tid < 384 ? tid : 128); kl_ = kl_ < 0 ? 0 : kl_; P_ = positions[(D_).rowb + (size_t)kl_ * (D_).dil + (D_).res]; } while (0)
    bf16x8 qr[4]; int posqi = 0, posn = 0;
    DA_POSLOAD(posn, d);
    posf[tid] = (float)posn;
    DA_DMA_K(d);
    DA_QLOAD(qr, posqi, d);
#define DA_TOP(N) do { ATT_WAIT_BAR(N); _Pragma("unroll") for (int d0_ = 0; d0_ < 4; ++d0_) asm volatile("" : "+v"(qr[d0_])); asm volatile("" : "+v"(posqi)); } while (0)
    DA_TOP(0);
#pragma unroll 1
    for (;;) {
        DA_DMA_V(d);
        const int un = u + F.G; const bool has_next = un < NUNITS;
        const DilUnit dn = dil_decode(has_next ? un : u);
        if (has_next) DA_POSLOAD(posn, dn);
        __builtin_amdgcn_sched_barrier(0);
        const float posq = (float)posqi;
        const float slope2 = __builtin_amdgcn_exp2f(-(float)(d.h + 1)) * LOG2E;
        const int j0 = wid >> 1;
        f32x16 p0[3], p1[3];
#pragma unroll
        for (int jj = 0; jj < 3; ++jj) {
            const int j = j0 + jj;
            att::qkt<4>(p0[jj], p1[jj], lds + DA_K + j * 8192, qr, r32, hi);
            const int relb = 128 + 32 * wid + r32 - 64 * j, klb = d.q0 - 128 + 64 * j;
            const int lo = max(relb - 128, -klb);
            const unsigned spanp1 = (unsigned)max(relb - lo + 1, 0);
            const int ub = 4 * hi - lo;
            const LAS f32x4* pk4 = (const LAS f32x4*)(posf + 64 * j + 4 * hi);
#pragma unroll
            for (int gq = 0; gq < 4; ++gq) {
                const f32x4 k0v = pk4[2 * gq], k1v = pk4[2 * gq + 8];
#pragma unroll
                for (int c = 0; c < 4; ++c) { const int r = 4 * gq + c;
                    { const bool ok = (unsigned)(ub + 8 * gq + c) < spanp1; const float dd = posq - k0v[c]; const float v = __builtin_fmaf(-slope2, __builtin_fabsf(dd), p0[jj][r]); p0[jj][r] = ok ? v : -INFINITY; }
                    { const bool ok = (unsigned)(ub + 8 * gq + c + 32) < spanp1; const float dd = posq - k1v[c]; const float v = __builtin_fmaf(-slope2, __builtin_fabsf(dd), p1[jj][r]); p1[jj][r] = ok ? v : -INFINITY; } }
            }
        }
        float m;
        { float a = max3f(p0[0][0], p0[0][1], p1[0][0]), bq = max3f(p0[0][2], p0[0][3], p1[0][1]); a = max3f(a, p1[0][2], p1[0][3]);
#pragma unroll
          for (int jj = 0; jj < 3; ++jj)
#pragma unroll
              for (int r = (jj == 0 ? 4 : 0); r < 16; r += 4) { a = max3f(a, p0[jj][r], p0[jj][r + 1]); bq = max3f(bq, p0[jj][r + 2], p0[jj][r + 3]); a = max3f(a, p1[jj][r], p1[jj][r + 1]); bq = max3f(bq, p1[jj][r + 2], p1[jj][r + 3]); }
          float rm = fmaxf(a, bq); { auto rr = __builtin_amdgcn_permlane32_swap(__float_as_uint(rm), __float_as_uint(rm), false, false); rm = fmaxf(__uint_as_float(rr[0]), __uint_as_float(rr[1])); }
          m = rm; }
        float l_run = 0.f;
#pragma unroll
        for (int jj = 0; jj < 3; ++jj) { float s0 = 0.f, s1 = 0.f;
#pragma unroll
            for (int r = 0; r < 16; ++r) { p0[jj][r] = fast_exp2(p0[jj][r] - m); p1[jj][r] = fast_exp2(p1[jj][r] - m); s0 += p0[jj][r]; s1 += p1[jj][r]; }
            l_run += s0 + s1; }
        ATT_WAIT_BAR(0);
        bf16x8 qn[4]; int posqn = 0;
        if (has_next) {
            posf[tid] = (float)posn;
            DA_DMA_K(dn);
            DA_QLOAD(qn, posqn, dn);
        } else {
#pragma unroll
            for (int d0 = 0; d0 < 4; ++d0) qn[d0] = qr[d0];
        }
        __builtin_amdgcn_sched_barrier(0);
        f32x16 o[2];
#pragma unroll
        for (int r = 0; r < 16; ++r) { o[0][r] = 0.f; o[1][r] = 0.f; }
#pragma unroll
        for (int jj = 0; jj < 3; ++jj) att::pv_step(o, p0[jj], p1[jj], lds + DA_V + (j0 + jj) * 8192, lane, hi);
        const float l = att::finish_rows(o, l_run, wsf, stg, r32, hi);
        const size_t qrow = d.rowb + (size_t)(d.q0 + 32 * wid + r32) * d.dil + d.res;
        if (hi == 0) lse[((size_t)d.g * T + qrow) * 8 + d.h] = m + __builtin_amdgcn_logf(l);
        bf16_t* obase = o3 + (size_t)d.g * T * DSAW + d.h * 64;
#pragma unroll
        for (int i = 0; i < 4; ++i) { const int row = i * 8 + (lane >> 3), ch = lane & 7; const u32x4 v = *(const LAS u32x4*)(stg + row * 64 + ch * 8);
            const size_t orow = d.rowb + (size_t)(d.q0 + 32 * wid + row) * d.dil + d.res;
            *(u32x4*)(obase + orow * DSAW + ch * 8) = v; }
        if (!has_next) break;
        u = un; d = dn; posqi = posqn;
#pragma unroll
        for (int d0 = 0; d0 < 4; ++d0) qr[d0] = qn[d0];
        DA_TOP(4);
    }
    ATT_WAIT_BAR(0);
#undef DA_TOP
#undef DA_SLAB
#undef DA_DMA_K
#undef DA_DMA_V
#undef DA_QLOAD
#undef DA_POSLOAD
}
__device__ __forceinline__ void merge_pass(const Frame& F, const bf16_t* o3, const float* lse, bf16_t* mix) {
    const int gw = F.bid * NWAVES + F.wave, NGW = F.G * NWAVES, lane = F.lane, h = lane >> 3;
    float l[3], ln[3]; u32x4 a[3], an[3];
#define MG_LOAD(L_, A_, m_) do { _Pragma("unroll") for (int g_ = 0; g_ < 3; ++g_) { L_[g_] = lse[((size_t)g_ * T + (m_)) * 8 + h]; A_[g_] = *(const u32x4*)(o3 + ((size_t)g_ * T + (m_)) * DSAW + lane * 8); } } while (0)
    if (gw < T) MG_LOAD(l, a, gw);
    for (int m = gw; m < T; m += NGW) {
        const int mn = m + NGW < T ? m + NGW : m;
        MG_LOAD(ln, an, mn);
        __builtin_amdgcn_sched_barrier(0);
        const float mx = fmaxf(l[0], fmaxf(l[1], l[2]));
        float l0 = fast_exp2(l[0] - mx), l1 = fast_exp2(l[1] - mx), l2 = fast_exp2(l[2] - mx);
        const float inv = fast_rcp(l0 + l1 + l2); l0 *= inv; l1 *= inv; l2 *= inv;
        u32x4 w;
#pragma unroll
        for (int k = 0; k < 4; ++k) w[k] = pk2(l0 * bflo(a[0][k]) + l1 * bflo(a[1][k]) + l2 * bflo(a[2][k]), l0 * bfhi(a[0][k]) + l1 * bfhi(a[1][k]) + l2 * bfhi(a[2][k]));
        *(u32x4*)(mix + (size_t)m * DSAW + lane * 8) = w;
#pragma unroll
        for (int g = 0; g < 3; ++g) { l[g] = ln[g]; a[g] = an[g]; }
    }
#undef MG_LOAD
}

__device__ __forceinline__ void mla_pv(f32x16 (&o)[2], const u32x4 (&pw)[4], const LAS unsigned char* Vslot, int lane, int hi) {
    const LAS unsigned char* vb = Vslot + ((lane >> 4) & 1) * 32 + (lane & 3) * 8 + (4 * hi + ((lane & 15) >> 2)) * 64;
#pragma unroll
    for (int ks = 0; ks < 4; ++ks)
#pragma unroll
        for (int d0 = 0; d0 < 2; ++d0) {
            const s16x4 lo = __builtin_bit_cast(s16x4, __builtin_amdgcn_ds_read_tr16_b64_v4i16((LAS att::v4i16_t*)(vb + d0 * 4096 + ks * 1024)));
            const s16x4 hh = __builtin_bit_cast(s16x4, __builtin_amdgcn_ds_read_tr16_b64_v4i16((LAS att::v4i16_t*)(vb + d0 * 4096 + ks * 1024 + 512)));
            const bf16x8 vf = (bf16x8){lo[0], lo[1], lo[2], lo[3], hh[0], hh[1], hh[2], hh[3]};
            o[d0] = __builtin_amdgcn_mfma_f32_32x32x16_bf16(__builtin_bit_cast(bf16x8, pw[ks]), vf, o[d0], 0, 0, 0);
        }
}
constexpr int H4_K = 0, H4_KS = 12288, H4_V = 4 * H4_KS, H4_VS = 8192, H4_WS = H4_V + 3 * H4_VS, H4_OST = H4_WS + 2048, H4_END = H4_OST + 32768;
static_assert(H4_END <= MISC_OFF, "mla attention (hand-interleaved) LDS");
__device__ __forceinline__ void mla_attn_phase4(const Frame& F, const bf16_t* Q, const bf16_t* KV, const bf16_t* KR, bf16_t* O) {
    const int lane = F.lane, wid = F.wave, r32 = lane & 31, hi = lane >> 5;
    LAS unsigned char* lds = F.lds;
    LAS float* wsf = (LAS float*)(lds + H4_WS) + wid * 64;
    LAS bf16_t* stg = (LAS bf16_t*)(lds + H4_OST) + wid * 2048;
    const unsigned ldsb = att::lds_addr(lds);
    volatile LAS unsigned* redo_flag = (volatile LAS unsigned*)(lds + MISC_OFF) + 24;
    const int vcu = (F.G % 8 == 0) ? (F.bid % 8) * (F.G / 8) + F.bid / 8 : F.bid;
    constexpr int NQB = SEQ / 256;
    constexpr int NUNITS = BATCH * NH * NQB;
    const int nper = (NUNITS + F.G - 1) / F.G;
    const LAS unsigned char* kp0 = lds + H4_K + hi * 1024 + r32 * 16;
    const LAS unsigned char* vp0 = lds + H4_V + ((lane >> 4) & 1) * 32 + (lane & 3) * 8 + (4 * hi + ((lane & 15) >> 2)) * 64;
#define H4_SB() __builtin_amdgcn_sched_barrier(0)
#define H4_PIN(x) asm volatile("" : "+v"(x))
#define H4_WAIT_BAR(N) asm volatile("s_waitcnt vmcnt(" #N ") lgkmcnt(0)\n\ts_barrier" ::: "memory")
#define H4_WAIT3() do { if (wid < 4) { H4_WAIT_BAR(3); } else { H4_WAIT_BAR(2); } } while (0)
#define H4_VTR(p) __builtin_bit_cast(s16x4, __builtin_amdgcn_ds_read_tr16_b64_v4i16((LAS att::v4i16_t*)(p)))
#define H4_MFMA(a, b, c) __builtin_amdgcn_mfma_f32_32x32x16_bf16(a, b, c, 0, 0, 0)
#define H4_Z (f32x16){0.f, 0.f, 0.f, 0.f, 0.f, 0.f, 0.f, 0.f, 0.f, 0.f, 0.f, 0.f, 0.f, 0.f, 0.f, 0.f}
    for (int i = 0; i < nper; ++i) {
        int bh, qb;
        if (F.G == 256) { const int s = vcu & 7; bh = vcu >> 3; const int k2 = i >> 1; qb = (i & 1) ? (16 * k2 + 15 - s) : (16 * k2 + s); }
        else { const int it = i * F.G + F.bid; if (it >= NUNITS) break; bh = it / NQB; qb = NQB - 1 - (it % NQB); }
        bool safe = false;
        for (;;) {
        const int b = bh / NH, h = bh % NH;
        const size_t rowb = (size_t)b * SEQ; const int q0 = qb * 256;
        const int NT = 4 * (qb + 1);
        int ln_ = threadIdx.x & 63; asm volatile("" : "+v"(ln_));
        const bf16_t* ksrc = KV + (rowb + ln_) * KVC + h * 128 + wid * 8;
        const bf16_t* rsrc = KR + (rowb + ln_) * 32 + (wid & 3) * 8;
        const bf16_t* vsrc = KV + (rowb + 16 * (wid & 3) + (ln_ >> 2)) * KVC + h * 128 + 64 + (wid >> 2) * 32 + (ln_ & 3) * 8;
#define H4_DMA_K(t, slot) do { \
        att::glds16(ksrc + (size_t)(t) * 64 * KVC, (unsigned)__builtin_amdgcn_readfirstlane(ldsb + H4_K + (slot) * H4_KS + wid * 1024)); \
        if (wid < 4) att::glds16(rsrc + (size_t)(t) * 64 * 32, (unsigned)__builtin_amdgcn_readfirstlane(ldsb + H4_K + (slot) * H4_KS + (8 + wid) * 1024)); } while (0)
#define H4_DMA_V(t, slot) att::glds16(vsrc + (size_t)(t) * 64 * KVC, (unsigned)__builtin_amdgcn_readfirstlane(ldsb + H4_V + (slot) * H4_VS + wid * 1024))
        H4_DMA_K(0, 0); H4_DMA_V(0, 0); H4_DMA_K(1, 1);
        bf16x8 qr[6];
        { const bf16_t* qp = Q + (rowb + q0 + 32 * wid + (ln_ & 31)) * QC + h * HQ + (ln_ >> 5) * 8;
#pragma unroll
          for (int d0 = 0; d0 < 6; ++d0) qr[d0] = *(const bf16x8*)(qp + d0 * 16); }
        float mhat = 0.f, l_reg = 0.f; f32x16 o[2], pA0, pA1, pB0, pB1, negm; bool resc = false;
#pragma unroll
        for (int r = 0; r < 16; ++r) { o[0][r] = 0.f; o[1][r] = 0.f; negm[r] = 0.f; }
        H4_PIN(negm);
        const int qrel = 32 * wid + r32;
        int sp = 0, sc = 0, sn = 1, kc = 0;
#define H4_ROT() do { sp = sc; sc = sn; sn = (sn == 2) ? 0 : sn + 1; kc = (kc + 1) & 3; } while (0)
#define H4_CMASK(P0, P1, t) do { const int jb_ = (t) - (NT - 4); if (jb_ >= 0) { _Pragma("unroll") for (int r = 0; r < 16; ++r) { const int kv_ = 64 * jb_ + att::crow(r, hi); if (kv_ > qrel) P0[r] = -INFINITY; if (kv_ + 32 > qrel) P1[r] = -INFINITY; } } } while (0)
#define H4_RESC() do { if (resc) { LDS_WAIT(); _Pragma("unroll") for (int d_ = 0; d_ < 2; ++d_) _Pragma("unroll") for (int r = 0; r < 16; ++r) o[d_][r] *= wsf[att::crow(r, hi)]; } } while (0)
        H4_DMA_K(2, 2);
#pragma unroll
        for (int d0 = 0; d0 < 6; ++d0) H4_PIN(qr[d0]);
        if (wid < 4) { H4_WAIT_BAR(5); } else { H4_WAIT_BAR(3); }
        { const LAS unsigned char* kb = kp0;
#pragma unroll
          for (int d0 = 0; d0 < 6; ++d0) { const bf16x8 b0 = *(const LAS bf16x8*)(kb + d0 * 2048), b1 = *(const LAS bf16x8*)(kb + d0 * 2048 + 512);
              if (d0 == 0) { pA0 = H4_MFMA(b0, qr[0], H4_Z); pA1 = H4_MFMA(b1, qr[0], H4_Z); } else { pA0 = H4_MFMA(b0, qr[d0], pA0); pA1 = H4_MFMA(b1, qr[d0], pA1); } } }
        H4_CMASK(pA0, pA1, 0);
        asm volatile("s_nop 15\n\ts_nop 7" : "+v"(pA0), "+v"(pA1));
        { float a = max3f(pA0[0], pA0[1], pA1[0]), bq = max3f(pA0[2], pA0[3], pA1[1]); a = max3f(a, pA1[2], pA1[3]);
#pragma unroll
          for (int r = 4; r < 16; r += 4) { a = max3f(a, pA0[r], pA0[r + 1]); bq = max3f(bq, pA0[r + 2], pA0[r + 3]); a = max3f(a, pA1[r], pA1[r + 1]); bq = max3f(bq, pA1[r + 2], pA1[r + 3]); }
          float rm = fmaxf(a, bq); { auto rr = __builtin_amdgcn_permlane32_swap(__float_as_uint(rm), __float_as_uint(rm), false, false); rm = fmaxf(__uint_as_float(rr[0]), __uint_as_float(rr[1])); }
          mhat = rm;
#pragma unroll
          for (int r = 0; r < 16; ++r) { pA0[r] = fast_exp2(pA0[r] - rm); pA1[r] = fast_exp2(pA1[r] - rm); negm[r] = -rm; }
          H4_PIN(negm); }
        H4_WAIT_BAR(0);
        if (F.tid == 0) *redo_flag = 0u;
        H4_DMA_K(3, 3); H4_DMA_V(1, 1);
        H4_ROT();
        bf16x8 kf[12];
#pragma unroll
        for (int j = 0; j < 4; ++j) { kf[2 * j] = *(const LAS bf16x8*)(kp0 + kc * H4_KS + j * 2048); kf[2 * j + 1] = *(const LAS bf16x8*)(kp0 + kc * H4_KS + j * 2048 + 512); }
        H4_WAIT3();
        s16x4 vlo[4], vhi[4]; u32x4 pw0, pw1, pw2, pw3;
#define H4_PKW(P, B) pk2(P[B], P[B + 1])
#define H4_PAF(k) __builtin_bit_cast(bf16x8, pw##k)
#define H4_VFR(s_) (bf16x8){vlo[s_][0], vlo[s_][1], vlo[s_][2], vlo[s_][3], vhi[s_][0], vhi[s_][1], vhi[s_][2], vhi[s_][3]}
#define H4_MX3(a, b, c) __builtin_fmaxf(__builtin_fmaxf((a), (b)), (c))
#define H4_GAPA(MF, A0, A1, A2, A3, W0, W1, PW) do { MF; sacc += A0; sacc += A1; sacc += A2; sacc += A3; H4_PIN(sacc); W0; W1; H4_PIN(PW); H4_SB(); } while (0)
#define H4_GAPM(MF) do { MF; H4_SB(); } while (0)
#define H4_GAPB(MF, X, B) do { MF; X[B] = fast_exp2(X[B]); X[B + 1] = fast_exp2(X[B + 1]); X[B + 2] = fast_exp2(X[B + 2]); X[B + 3] = fast_exp2(X[B + 3]); H4_PIN(X); H4_SB(); } while (0)
#define H4_VRD(s_, i) do { vlo[s_] = H4_VTR(vp_ + (((i) >> 2) * 4096 + ((i) & 3) * 1024)); vhi[s_] = H4_VTR(vp_ + (((i) >> 2) * 4096 + ((i) & 3) * 1024 + 512)); } while (0)
#define H4_KRD(G, j) do { if (G) { kf[2 * (j)] = *(const LAS bf16x8*)(kn_ + (j) * 2048); kf[2 * (j) + 1] = *(const LAS bf16x8*)(kn_ + (j) * 2048 + 512); H4_SB(); } } while (0)
#define H4_KRR(j) do { kf[2 * (j)] = *(const LAS bf16x8*)(kc_ + (j) * 2048); kf[2 * (j) + 1] = *(const LAS bf16x8*)(kc_ + (j) * 2048 + 512); } while (0)
#define H4_STEP(C0, C1, P0, P1, t, GK, GV, GL, BAND) do { H4_SB(); \
        const LAS unsigned char* vp_ = vp0 + sp * H4_VS; const LAS unsigned char* kn_ = kp0 + ((kc + 1) & 3) * H4_KS; const LAS unsigned char* kc_ = kp0 + kc * H4_KS; \
        float sacc = (P0[0] + P0[1]); \
        H4_GAPA(C0 = H4_MFMA(kf[0], qr[0], negm), P0[2], P0[3], P0[4], P0[5],     pw0[0] = H4_PKW(P0, 0), pw0[1] = H4_PKW(P0, 2), pw0); \
        H4_GAPA(C1 = H4_MFMA(kf[1], qr[0], negm), P0[6], P0[7], P0[8], P0[9],     pw0[2] = H4_PKW(P0, 4), pw0[3] = H4_PKW(P0, 6), pw0); \
        H4_GAPA(C0 = H4_MFMA(kf[2], qr[1], C0),   P0[10], P0[11], P0[12], P0[13], pw1[0] = H4_PKW(P0, 8), pw1[1] = H4_PKW(P0, 10), pw1); \
        H4_GAPA(C1 = H4_MFMA(kf[3], qr[1], C1),   P0[14], P0[15], P1[0], P1[1],   pw1[2] = H4_PKW(P0, 12), pw1[3] = H4_PKW(P0, 14), pw1); \
        H4_KRR(4); H4_SB(); H4_GAPA(C0 = H4_MFMA(kf[4], qr[2], C0),   P1[2], P1[3], P1[4], P1[5],     pw2[0] = H4_PKW(P1, 0), pw2[1] = H4_PKW(P1, 2), pw2); \
        H4_KRR(5); H4_SB(); H4_GAPA(C1 = H4_MFMA(kf[5], qr[2], C1),   P1[6], P1[7], P1[8], P1[9],     pw2[2] = H4_PKW(P1, 4), pw2[3] = H4_PKW(P1, 6), pw2); \
        H4_VRD(0, 0); H4_SB(); H4_GAPA(C0 = H4_MFMA(kf[6], qr[3], C0),   P1[10], P1[11], P1[12], P1[13], pw3[0] = H4_PKW(P1, 8), pw3[1] = H4_PKW(P1, 10), pw3); \
        H4_VRD(1, 4); H4_SB(); H4_GAPA(C1 = H4_MFMA(kf[7], qr[3], C1),   P1[14], P1[15], 0.f, 0.f,       pw3[2] = H4_PKW(P1, 12), pw3[3] = H4_PKW(P1, 14), pw3); \
        H4_VRD(2, 1); H4_KRD(GL, 0); H4_SB(); H4_GAPM(C0 = H4_MFMA(kf[8], qr[4], C0)); H4_VRD(3, 5); H4_KRD(GL, 1); H4_SB(); H4_GAPM(C1 = H4_MFMA(kf[9], qr[4], C1)); if (GK) { H4_DMA_K((t) + 3, (kc + 3) & 3); H4_SB(); } \
        H4_KRD(GL, 2); H4_GAPM(C0 = H4_MFMA(kf[10], qr[5], C0)); if (GV) { H4_DMA_V((t) + 1, sn); H4_SB(); } \
        H4_KRD(GL, 3); H4_GAPM(C1 = H4_MFMA(kf[11], qr[5], C1)); \
        l_reg += sacc; \
        if (BAND) H4_CMASK(C0, C1, t); \
        resc = false; \
        if (safe) { float a = H4_MX3(C0[0], C0[1], C1[0]), bq = H4_MX3(C0[2], C0[3], C1[1]); a = H4_MX3(a, C1[2], C1[3]); \
          _Pragma("unroll") for (int r = 4; r < 16; r += 4) { a = H4_MX3(a, C0[r], C0[r + 1]); bq = H4_MX3(bq, C0[r + 2], C0[r + 3]); a = H4_MX3(a, C1[r], C1[r + 1]); bq = H4_MX3(bq, C1[r + 2], C1[r + 3]); } \
          float rm = __builtin_fmaxf(a, bq); { auto rr = __builtin_amdgcn_permlane32_swap(__float_as_uint(rm), __float_as_uint(rm), false, false); rm = __builtin_fmaxf(__uint_as_float(rr[0]), __uint_as_float(rr[1])); } \
          if (__builtin_expect(__any(rm > 8.f), 0)) { const float dl = __builtin_fmaxf(rm, 0.f); mhat += dl; \
              _Pragma("unroll") for (int r = 0; r < 16; ++r) { C0[r] -= dl; C1[r] -= dl; } \
              _Pragma("unroll") for (int r = 0; r < 16; ++r) negm[r] = -mhat; H4_PIN(negm); \
              const float f = fast_exp2(-dl); l_reg *= f; if (hi == 0) { int ri_ = threadIdx.x & 31; asm volatile("" : "+v"(ri_)); wsf[ri_] = f; } resc = true; } } \
        H4_SB(); \
        H4_GAPB(o[0] = H4_MFMA(H4_PAF(0), H4_VFR(0), o[0]), C0, 0); \
        H4_VRD(0, 2); H4_SB(); H4_GAPB(o[1] = H4_MFMA(H4_PAF(0), H4_VFR(1), o[1]), C0, 4); \
        H4_VRD(1, 6); H4_SB(); H4_GAPB(o[0] = H4_MFMA(H4_PAF(1), H4_VFR(2), o[0]), C0, 8); \
        H4_VRD(2, 3); H4_SB(); H4_GAPB(o[1] = H4_MFMA(H4_PAF(1), H4_VFR(3), o[1]), C0, 12); \
        H4_VRD(3, 7); H4_SB(); H4_GAPB(o[0] = H4_MFMA(H4_PAF(2), H4_VFR(0), o[0]), C1, 0); \
        H4_GAPB(o[1] = H4_MFMA(H4_PAF(2), H4_VFR(1), o[1]), C1, 4); \
        H4_GAPB(o[0] = H4_MFMA(H4_PAF(3), H4_VFR(2), o[0]), C1, 8); \
        H4_GAPB(o[1] = H4_MFMA(H4_PAF(3), H4_VFR(3), o[1]), C1, 12); \
        } while (0)
        int t = 1;
        for (; t + 5 < NT; t += 2) {
            H4_STEP(pB0, pB1, pA0, pA1, t, true, true, true, false);     H4_WAIT3(); H4_RESC(); H4_ROT();
            H4_STEP(pA0, pA1, pB0, pB1, t + 1, true, true, true, false); H4_WAIT3(); H4_RESC(); H4_ROT();
        }
#define H4_ENDW(tt) do { if ((tt) + 3 < NT) { H4_WAIT3(); } else if ((tt) + 2 < NT) { H4_WAIT_BAR(1); } else { H4_WAIT_BAR(0); } } while (0)
        for (; t + 1 < NT; t += 2) {
            H4_STEP(pB0, pB1, pA0, pA1, t, (t + 3 < NT), (t + 1 < NT), (t + 1 < NT), true);         H4_ENDW(t);     H4_RESC(); H4_ROT();
            H4_STEP(pA0, pA1, pB0, pB1, t + 1, (t + 4 < NT), (t + 2 < NT), (t + 2 < NT), true);     H4_ENDW(t + 1); H4_RESC(); H4_ROT();
        }
        H4_STEP(pB0, pB1, pA0, pA1, NT - 1, false, false, false, true); H4_RESC();
        { float sacc = pB0[0] + pB0[1];
#pragma unroll
          for (int r = 2; r < 16; ++r) sacc += pB0[r];
#pragma unroll
          for (int r = 0; r < 16; ++r) sacc += pB1[r];
          l_reg += sacc;
          u32x4 pw[4];
          pw[0] = (u32x4){H4_PKW(pB0, 0), H4_PKW(pB0, 2), H4_PKW(pB0, 4), H4_PKW(pB0, 6)}; pw[1] = (u32x4){H4_PKW(pB0, 8), H4_PKW(pB0, 10), H4_PKW(pB0, 12), H4_PKW(pB0, 14)};
          pw[2] = (u32x4){H4_PKW(pB1, 0), H4_PKW(pB1, 2), H4_PKW(pB1, 4), H4_PKW(pB1, 6)}; pw[3] = (u32x4){H4_PKW(pB1, 8), H4_PKW(pB1, 10), H4_PKW(pB1, 12), H4_PKW(pB1, 14)};
          H4_SB(); mla_pv(o, pw, lds + H4_V + sc * H4_VS, lane, hi); }
#undef H4_DMA_K
#undef H4_DMA_V
#undef H4_ROT
#undef H4_CMASK
#undef H4_RESC
#undef H4_PKW
#undef H4_PAF
#undef H4_VFR
#undef H4_MX3
#undef H4_GAPA
#undef H4_GAPM
#undef H4_GAPB
#undef H4_VRD
#undef H4_KRD
#undef H4_KRR
#undef H4_STEP
#undef H4_ENDW
        int le_ = threadIdx.x & 63; asm volatile("" : "+v"(le_));
        if (__any(!(l_reg < 1e18f)) && le_ == 0) *redo_flag = 1u;
        (void)att::finish_rows(o, l_reg, wsf, stg, le_ & 31, le_ >> 5);
        bf16_t* ob = O + (rowb + q0 + 32 * wid) * DM + h * 64;
#pragma unroll
        for (int i2 = 0; i2 < 4; ++i2) { const int row = i2 * 8 + (le_ >> 3), ch = le_ & 7; const u32x4 v = *(const LAS u32x4*)(stg + row * 64 + ch * 8); *(u32x4*)(ob + (size_t)row * DM + ch * 8) = v; }
        ATT_WAIT_BAR(0);
        const unsigned redo = __builtin_amdgcn_readfirstlane(*redo_flag);
        if (safe || redo == 0u) break;
        safe = true;
        }
    }
#undef H4_SB
#undef H4_PIN
#undef H4_WAIT_BAR
#undef H4_WAIT3
#undef H4_VTR
#undef H4_MFMA
#undef H4_Z
}

__device__ __forceinline__ void router_pass(const Frame& F, const bf16_t* xb, const float* g, const float* wrouter, float* r3, int* e01, float* gwt, int* cnt, int* list, float* rsrow, unsigned* x8) {
    LAS float* wr = (LAS float*)F.lds;
    LAS int* lc = (LAS int*)(F.lds + 32768);
    for (int i = F.tid; i < DM * NEXP / 4; i += NWAVES * 64) ((LAS f32x4*)wr)[i] = ((const f32x4*)wrouter)[i];
    for (int i = F.bid * NWAVES * 64 + F.tid; i < 2 * MOE_MAXROWS; i += F.G * NWAVES * 64) { list[i] = -1; rsrow[i] = 1.f; }
    f32x4 gv[4]; load_gain(g, gv, F.lane);
    const int lane = F.lane;
    for (int ch = F.bid; ch < T / 128; ch += F.G) {
        if (F.tid < 16) lc[F.tid] = 0;
        __syncthreads();
        f32x4 v[4]; u32x2 vn[4];
        { const u32x2* xr = (const u32x2*)(xb + (size_t)(ch * 128 + F.wave * 16) * DM) + lane;
#pragma unroll
          for (int j = 0; j < 4; ++j) vn[j] = xr[64 * j]; }
        for (int rr = 0; rr < 16; ++rr) {
            const int m = ch * 128 + F.wave * 16 + rr;
#pragma unroll
            for (int j = 0; j < 4; ++j) v[j] = (f32x4){bflo(vn[j].x), bfhi(vn[j].x), bflo(vn[j].y), bfhi(vn[j].y)};
            { const int mn = rr < 15 ? m + 1 : m; const u32x2* xr = (const u32x2*)(xb + (size_t)mn * DM) + lane;
#pragma unroll
              for (int j = 0; j < 4; ++j) vn[j] = xr[64 * j]; }
            __builtin_amdgcn_sched_barrier(0);
            { float s = 0.f;
#pragma unroll
              for (int j = 0; j < 4; ++j) s += (v[j].x * v[j].x + v[j].y * v[j].y) + (v[j].z * v[j].z + v[j].w * v[j].w);
              const float r = __builtin_amdgcn_rsqf(wave_sum(s) * (1.f / DM) + RMS_EPS);
              if (lane == 0) r3[m] = r;
#pragma unroll
              for (int j = 0; j < 4; ++j) x8[(size_t)m * (DM / 4) + 64 * j + lane] = pk4_fp8(v[j].x * 2.f, v[j].y * 2.f, v[j].z * 2.f, v[j].w * 2.f);
#pragma unroll
              for (int j = 0; j < 4; ++j) v[j] = v[j] * r * gv[j]; }
            float lg[NEXP];
#pragma unroll
            for (int e = 0; e < NEXP; ++e) lg[e] = 0.f;
#pragma unroll
            for (int j = 0; j < 4; ++j)
#pragma unroll
                for (int k = 0; k < 4; ++k) { const int col = 4 * (64 * j + lane) + k; const f32x4 w0 = *(const LAS f32x4*)(wr + col * 8), w1 = *(const LAS f32x4*)(wr + col * 8 + 4); const float xv = v[j][k];
                    lg[0] += xv * w0.x; lg[1] += xv * w0.y; lg[2] += xv * w0.z; lg[3] += xv * w0.w; lg[4] += xv * w1.x; lg[5] += xv * w1.y; lg[6] += xv * w1.z; lg[7] += xv * w1.w; }
#pragma unroll
            for (int e = 0; e < NEXP; ++e) lg[e] = wave_sum(lg[e]);
            int i0 = 0; float b0 = lg[0];
#pragma unroll
            for (int e = 1; e < NEXP; ++e) if (lg[e] > b0) { b0 = lg[e]; i0 = e; }
            int i1 = -1; float b1 = -INFINITY;
#pragma unroll
            for (int e = 0; e < NEXP; ++e) if (e != i0 && lg[e] > b1) { b1 = lg[e]; i1 = e; }
            const float w1 = 1.f / (1.f + expf(b0 - b1)), w0 = 1.f - w1;
            if (lane == 0) { e01[m] = i0 | (i1 << 8); gwt[2 * m] = w0; gwt[2 * m + 1] = w1; lds_add(&lc[i0], 1); lds_add(&lc[8 + i1], 1); }
        }
        __syncthreads();
        if (F.tid < 16) cnt[ch * 16 + F.tid] = lc[F.tid];
        __syncthreads();
    }
}
__device__ __forceinline__ void list_pass(const Frame& F, const int* e01, const float* gwt, const int* cnt, int* list, float* gws, int* bases, const float* r3, float* rsrow, int* tflag, int tailrow0) {
    LAS int* tot = (LAS int*)F.lds;
    LAS int* pre = tot + 16;
    LAS int* lc = tot + 32;
    LAS int* bs = tot + 48;
    constexpr int NCH = T / 128;
    for (int ch = F.bid; ch < NCH; ch += F.G) {
        if (F.tid < 64) tot[F.tid] = 0;
        __syncthreads();
        for (int i = F.tid; i < NCH * 16; i += NWAVES * 64) { const int c = cnt[i]; lds_add(&tot[i & 15], c); if ((i >> 4) < ch) lds_add(&pre[i & 15], c); }
        __syncthreads();
        if (F.tid < 2) { int acc = 0; for (int e = 0; e < NEXP; ++e) { bs[F.tid * 9 + e] = acc; acc += (tot[F.tid * 8 + e] + 255) & ~255; } bs[F.tid * 9 + 8] = acc; }
        __syncthreads();
        if (ch == 0 && F.tid < 18) bases[F.tid] = bs[F.tid];
        if (F.tid < 128) {
            const int m = ch * 128 + F.tid; const int ee = e01[m]; const int i0 = ee & 255, i1 = ee >> 8;
            const int p0 = lds_add(&lc[i0], 1), p1 = lds_add(&lc[8 + i1], 1);
            const int s0 = bs[i0] + pre[i0] + p0, s1 = bs[9 + i1] + pre[8 + i1] + p1;
            list[s0] = m; gws[s0] = gwt[2 * m] * (1.f / 512.f); list[MOE_MAXROWS + s1] = m; gws[MOE_MAXROWS + s1] = gwt[2 * m + 1] * (1.f / 512.f);
            tflag[m] = (s0 >= tailrow0 || s1 >= tailrow0) ? 1 : 0;
            const float rt = r3[m] * (1.f / 128.f); rsrow[s0] = rt; rsrow[MOE_MAXROWS + s1] = rt;
        }
        __syncthreads();
    }
}

#ifndef PHASE_MASK
#define PHASE_MASK 0xFFFFFFFFu
#endif
#define PH(n) (((PHASE_MASK) >> (n)) & 1u)
__global__ void __launch_bounds__(NWAVES * 64, 2) trunk_fwd(Args args) {
    extern __shared__ __attribute__((aligned(16))) unsigned char lds_raw[];
    Frame F;
    F.lds = (LAS unsigned char*)lds_raw;
    volatile LAS unsigned* MISC = (volatile LAS unsigned*)(F.lds + MISC_OFF);
    F.tid = threadIdx.x; F.lane = F.tid & 63; F.wave = __builtin_amdgcn_readfirstlane(F.tid >> 6);
    F.G = gridDim.x; F.bid = blockIdx.x;
    unsigned char* ws = args.ws;
    for (int u = F.tid; u < (LDS_BYTES - MISC_OFF) / 4; u += NWAVES * 64) ((LAS unsigned*)(F.lds + MISC_OFF))[u] = 0u;
    __syncthreads();
    XcdBarrier bar = xcd_barrier_post((unsigned*)(ws + WS_CTL) + CW_BAR, MISC + 8);
#define GRID_BAR() xcd_barrier(bar)

    const float* x = (const float*)args.in[0]; const int* positions = (const int*)args.in[1];
    const float* mix_g = (const float*)args.in[2]; const float* ffn_g = (const float*)args.in[3];
    float* out = args.out;
    bf16_t* Wqkv = (bf16_t*)(ws + WS_WQKV); bf16_t* Woa = (bf16_t*)(ws + WS_WOA); bf16_t* Wgu0 = (bf16_t*)(ws + WS_WGU0); bf16_t* Wd0 = (bf16_t*)(ws + WS_WD0);
    bf16_t* Win = (bf16_t*)(ws + WS_WIN); bf16_t* Wqup = (bf16_t*)(ws + WS_WQUP); bf16_t* Wkvup = (bf16_t*)(ws + WS_WKVUP); bf16_t* Wob = (bf16_t*)(ws + WS_WOB);
    bf16_t* Wmgu = (bf16_t*)(ws + WS_MOEGU); bf16_t* Wmd = (bf16_t*)(ws + WS_MOED);
    bf16_t* HN = (bf16_t*)(ws + WS_HN); bf16_t* QKV = (bf16_t*)(ws + WS_QKV); bf16_t* O3 = (bf16_t*)(ws + WS_O3); bf16_t* MIX = (bf16_t*)(ws + WS_MIX); bf16_t* ACT0 = (bf16_t*)(ws + WS_ACT0);
    bf16_t* CQ = (bf16_t*)(ws + WS_CQ); bf16_t* CKV = (bf16_t*)(ws + WS_CKV); bf16_t* KR = (bf16_t*)(ws + WS_KR);
    bf16_t* Qb = (bf16_t*)(ws + WS_Q); bf16_t* KVb = (bf16_t*)(ws + WS_KV); bf16_t* Ob = (bf16_t*)(ws + WS_O); bf16_t* ACTE = (bf16_t*)(ws + WS_ACTE);
    float* SSL = (float*)(ws + WS_SSL); float* SSQ = (float*)(ws + WS_SSQ); bf16_t* XB2 = (bf16_t*)(ws + WS_MOEGU); bf16_t* HN8 = (bf16_t*)(ws + WS_HN8); float* RS = (float*)(ws + WS_RS); float* RSROW = (float*)(ws + WS_RSROW); int* TFLAG = (int*)(ws + WS_TFLAG); bf16_t* XB1 = (bf16_t*)(ws + WS_XB1);
    float* COS = (float*)(ws + WS_COS); float* SIN = (float*)(ws + WS_SIN); float* LSE = (float*)(ws + WS_LSE);
    int* E01 = (int*)(ws + WS_E01); float* GWT = (float*)(ws + WS_GWT); int* LIST = (int*)(ws + WS_LIST); float* GWS = (float*)(ws + WS_GWS); int* CNT = (int*)(ws + WS_CNT); int* BASES = (int*)(ws + WS_BASES);
    const int gw = F.bid * NWAVES + F.wave, NGW = F.G * NWAVES;
    LAS float* scr = (LAS float*)(F.lds + F.wave * 16384);
    LAS unsigned char* scr8 = F.lds + F.wave * 16384;

    if (PH(0)) { const Frame FL = phase_frame(F);
        constexpr int I_QKV = 16 * 72, I_OA = 8 * 16, I_GU0 = 16 * 88, I_D0 = 44 * 16, I_IN = 16 * 24, I_QUP = 6 * 48, I_KVUP = 4 * 32, I_OB = 16 * 16;
        constexpr int NITEMS = I_QKV + I_OA + I_GU0 + I_D0 + I_IN + I_QUP + I_KVUP + I_OB;
        for (int it = gw; it < NITEMS; it += NGW) {
            int r = it;
            if (r < I_QKV) { tr_plain64((const float*)args.in[4], DM, QKVC, Wqkv, scr8, r, FL.lane); continue; } r -= I_QKV;
            if (r < I_OA) { tr_plain64((const float*)args.in[5], DSAW, DM, Woa, scr8, r, FL.lane); continue; } r -= I_OA;
            if (r < I_GU0) { tr_gateup64<true>((const float*)args.in[12], (const float*)args.in[13], DM, FF0, Wgu0, scr8, r, FL.lane, ffn_g); continue; } r -= I_GU0;
            if (r < I_D0) { tr_plain64((const float*)args.in[14], FF0, DM, Wd0, scr8, r, FL.lane); continue; } r -= I_D0;
            if (r < I_IN) { const int nblk = MLA_INP / 32, kb = r / nblk, nb = r % nblk; const int p_ = FL.lane & 31;
                tr_item((const float*)args.in[6], MLA_IN, 64 * kb, 32 * nb < QL + KVL ? 32 * nb + p_ : (32 * nb == QL + KVL ? QL + KVL + (p_ & 1) * 16 + (p_ >> 1) : -1), Win, DM, 32 * nb, scr, FL.lane, mix_g + DM); continue; } r -= I_IN;
            if (r < I_QUP) { const int nblk = QC / 32, kb = r / nblk, nb = r % nblk, n0 = 32 * nb, hh = n0 / HQ, cc = n0 % HQ; const int p = FL.lane & 31;
                const int scol = cc < 64 ? n0 + p : hh * HQ + 64 + (p & 1) * 16 + (p >> 1);
                tr_item((const float*)args.in[9], QC, 64 * kb, scol, Wqup, QL, n0, scr, FL.lane, (const float*)args.in[7]); continue; } r -= I_QUP;
            if (r < I_KVUP) { tr_plain64<true>((const float*)args.in[10], KVL, KVC, Wkvup, scr8, r, FL.lane, (const float*)args.in[8]); continue; } r -= I_KVUP;
            tr_plain64((const float*)args.in[11], DM, DM, Wob, scr8, r, FL.lane);
        }
        norm_pass(phase_frame(F), x, mix_g, HN);
        for (int i = F.bid * NWAVES * 64 + F.tid; i < T * 16; i += F.G * NWAVES * 64) { const int m = i >> 4, k = i & 15;
            float sk, ck; sincosf((float)positions[m] * powf(10000.0f, -(float)k / 16.0f), &sk, &ck); COS[i] = ck; SIN[i] = sk; }
    }
    GRID_BAR();
    if (PH(1)) { pg::StaticOrder S; S.init(T, QKVC, F.G, F.bid); pg::EpiQKV E{QKV, C2_DSA};
      pg::gemm_phase<pg::EpiQKV, pg::StaticOrder, false>(F.lds, HN, Wqkv, DM, DM, nullptr, S, E); }
    GRID_BAR();
    if (PH(2)) dilated_phase(phase_frame(F), QKV, positions, O3, LSE);
    GRID_BAR();
    if (PH(3)) merge_pass(phase_frame(F), O3, LSE, MIX);
    GRID_BAR();
    if (PH(4)) { pg::StaticOrder S; S.init(T, DM, F.G, F.bid); pg::EpiResBf<true, false> E{x, nullptr, XB1, SSQ};
      pg::gemm_phase<pg::EpiResBf<true, false>, pg::StaticOrder, false>(F.lds, MIX, Woa, DSAW, DSAW, nullptr, S, E); }
    GRID_BAR();
    if (PH(5)) { const Frame FL = phase_frame(F);
        for (int row = F.bid * NWAVES * 64 + F.tid; row < T; row += F.G * NWAVES * 64) RS[row] = pg::row_rrms(SSQ, row);
    }
    GRID_BAR();
    if (PH(6)) { pg::StaticOrder S; S.init(T, 2 * FF0, F.G, F.bid); pg::EpiSwiGLUT<1> E{ACT0, FF0, RS};
      pg::gemm_phase<pg::EpiSwiGLUT<1>, pg::StaticOrder, false>(F.lds, XB1, Wgu0, DM, DM, nullptr, S, E);
    }
    GRID_BAR();
    if (PH(7)) { pg::StaticOrder S; S.init(T, DM, F.G, F.bid); pg::EpiResBf<false, false> E{XB1, nullptr, XB2, SSQ};
      pg::gemm_phase<pg::EpiResBf<false, false>, pg::StaticOrder, false>(F.lds, ACT0, Wd0, FF0, FF0, nullptr, S, E); }
    GRID_BAR();
    if (PH(9)) { pg::StaticOrder S; S.init(T, MLA_INP, F.G, F.bid); pg::EpiLat E{CQ, CKV, KR, SSQ, SSL, COS, SIN};
      pg::gemm_phase<pg::EpiLat, pg::StaticOrder, false>(F.lds, XB2, Win, DM, DM, nullptr, S, E); }
    GRID_BAR();
    if (PH(11)) { pg::StaticOrder S; S.init(T, QC, F.G, F.bid); pg::EpiQRope E{Qb, COS, SIN, SSL};
      pg::gemm_phase<pg::EpiQRope, pg::StaticOrder, false>(F.lds, CQ, Wqup, QL, QL, nullptr, S, E); }
    if (PH(12)) { pg::StaticOrder S; S.init(T, KVC, F.G, F.bid); pg::EpiKVScale E{KVb, KVC, SSL};
      pg::gemm_phase<pg::EpiKVScale, pg::StaticOrder, false>(F.lds, CKV, Wkvup, KVL, KVL, nullptr, S, E); }
    GRID_BAR();
    if (PH(13)) mla_attn_phase4(phase_frame(F), Qb, KVb, KR, Ob);
    GRID_BAR();
    if (PH(14)) { pg::StaticOrder S; S.init(T, DM, F.G, F.bid); pg::EpiResBf<false, false> E{XB2, nullptr, HN, SSQ};
      pg::gemm_phase<pg::EpiResBf<false, false>, pg::StaticOrder, false>(F.lds, Ob, Wob, DM, DM, nullptr, S, E); }
    GRID_BAR();
    if (PH(15)) { router_pass(phase_frame(F), HN, ffn_g + DM, (const float*)args.in[15], RS, E01, GWT, CNT, LIST, RSROW, (unsigned*)HN8);
        __syncthreads();
        const Frame FL = phase_frame(F);
        constexpr int I_GU = 16 * 112, I_D = 56 * 16, I_E = I_GU + I_D;
        for (int it = gw; it < NEXP * I_E; it += NGW) {
            const int e = it / I_E; int r = it % I_E;
            if (r < I_GU) tr_gateup64<true, true>((const float*)args.in[16] + (size_t)e * DM * FFE, (const float*)args.in[17] + (size_t)e * DM * FFE, DM, FFE, Wmgu + (size_t)e * FFE * DM, scr8, r, FL.lane, ffn_g + DM);
            else tr_plain64<false, true>((const float*)args.in[18] + (size_t)e * FFE * DM, FFE, DM, Wmd + (size_t)e * DM * FFE / 2, scr8, r - I_GU, FL.lane);
        }
    }
    GRID_BAR();
    if (PH(16)) list_pass(phase_frame(F), E01, GWT, CNT, LIST, GWS, BASES, RS, RSROW, TFLAG, (2 * F.G / 4) * 256);
    GRID_BAR();
    {
        typedef pg::MoeOrder<2 * FFE / 256, 1, (long)FFE * DM> OrdGU;     typedef pg::MoeOrder<DM / 256, 1, (long)DM * FFE / 2> OrdDown; typedef pg::MoeOrder<DM / 256, MOE_TAIL_SPLIT, (long)DM * FFE / 2> OrdTail;
        const int nT0 = __builtin_amdgcn_readfirstlane(BASES[NEXP]) / 256, nT1 = __builtin_amdgcn_readfirstlane(BASES[9 + NEXP]) / 256, tmain = (2 * F.G) / 4;
#define MOE_BASES(S_, r_) do { _Pragma("unroll") for (int q_ = 0; q_ <= NEXP; ++q_) S_.base[q_] = __builtin_amdgcn_readfirstlane(BASES[(r_) * 9 + q_]); } while (0)
        const int tm0 = nT0 < tmain ? nT0 : tmain, tm1 = nT1 < tmain ? nT1 : tmain;
        const int off0 = ((((nT0 * (2 * FFE / 256)) % F.G) + 7) & ~7) % F.G;
        const int nq0 = (nT0 > tmain ? nT0 - tmain : 0) * (DM / 256) * MOE_TAIL_SPLIT;
        const int nq1 = (nT1 > tmain ? nT1 - tmain : 0) * (DM / 256) * MOE_TAIL_SPLIT;
        bf16_t* T1p = (bf16_t*)((ws + 1 * MiB) - (size_t)tmain * 256 * FFE);
#pragma unroll 1
        for (int k = 0; k < 3; ++k) {
            if (k == 2) {
                GRID_BAR();
                for (int rk = 0; rk < 2; ++rk)
                    for (int r = tmain * 256 + gw; r < (rk == 0 ? nT0 : nT1) * 256; r += NGW) { const int tok = LIST[rk * MOE_MAXROWS + r];
                        if (tok >= 0) { f32x4* orow = (f32x4*)(out + (size_t)tok * DM) + F.lane;
#pragma unroll
                            for (int j = 0; j < 4; ++j) orow[64 * j] = (f32x4){0.f, 0.f, 0.f, 0.f}; } }
                { OrdDown S; S.G = F.G; S.c = F.bid; MOE_BASES(S, 0);
                  S.t0 = 0; S.t1 = tm0; S.klen = 0;
                  pg::EpiMoeDown E{HN, LIST, GWS};
                  pg::gemm_phase<pg::EpiMoeDown, OrdDown, false, true, 0, 0>(F.lds, ACTE, Wmd, FFE / 2, FFE / 2, nullptr, S, E); }
                GRID_BAR();
#pragma unroll 1
                for (int r = 0; r < 2; ++r) {
                    OrdTail S; S.G = F.G; S.c = r == 0 ? F.bid : (F.bid - (nq0 % F.G) + F.G) % F.G; MOE_BASES(S, r);
                    S.t0 = tmain; S.t1 = r == 0 ? nT0 : nT1; S.klen = FFE / 2 / MOE_TAIL_SPLIT;
                    pg::EpiMoeDownAtomic E{out, LIST + r * MOE_MAXROWS, GWS + r * MOE_MAXROWS};
                    pg::gemm_phase<pg::EpiMoeDownAtomic, OrdTail, false, true, 0, 0>(F.lds, r == 0 ? ACTE : T1p, Wmd, FFE / 2 / MOE_TAIL_SPLIT, FFE / 2, nullptr, S, E);
                }
            }
            OrdGU S; S.G = F.G; S.c = k == 1 ? (F.bid - off0 + F.G) % F.G : F.bid; MOE_BASES(S, k == 0 ? 0 : 1);
            S.t0 = k == 1 ? tmain : 0; S.t1 = k == 0 ? nT0 : (k == 1 ? nT1 : tm1); S.klen = 0;
            if (k == 2) { const int nwg = tm1 * (2 * FFE / 256), ntc = nq0 + nq1;
                int Gm = F.G; asm volatile("" : "+s"(Gm));
                if (nwg % Gm == 0 && nwg >= 2 * Gm && ntc > 0 && 2 * ntc <= Gm) { S.rd_ntc = ntc; S.rd_R = nwg / Gm - 2; } }
            pg::EpiSwiGLU E{k == 1 ? T1p : ACTE, FFE, RSROW + (k == 0 ? 0 : MOE_MAXROWS)};
            pg::gemm_phase<pg::EpiSwiGLU, OrdGU, true, true, 0, 0>(F.lds, HN8, Wmgu, DM / 2, DM / 2, LIST + (k == 0 ? 0 : MOE_MAXROWS), S, E);
        }
        GRID_BAR();
        { OrdDown S; S.G = F.G; S.c = F.bid; MOE_BASES(S, 1);
          S.t0 = 0; S.t1 = tm1; S.klen = 0;
          pg::EpiMoeDown E{HN, LIST + MOE_MAXROWS, GWS + MOE_MAXROWS};
          pg::gemm_phase<pg::EpiMoeDown, OrdDown, false, true, 0, 0>(F.lds, ACTE, Wmd, FFE / 2, FFE / 2, nullptr, S, E); }
        GRID_BAR();
#undef MOE_BASES
    }
    if (PH(19)) { const Frame FL = phase_frame(F);
        f32x4 gv[4]; load_gain((const float*)args.in[19], gv, FL.lane);
        u32x2 vb[4], vnb[4]; int tf = 0, tfn = 0;
        if (gw < T) { const u32x2* xr = (const u32x2*)(HN + (size_t)gw * DM) + FL.lane; tf = TFLAG[gw];
#pragma unroll
            for (int j = 0; j < 4; ++j) vb[j] = xr[64 * j]; }
        for (int m = gw; m < T; m += NGW) {
            const int mn = m + NGW < T ? m + NGW : m;
            { const u32x2* xr = (const u32x2*)(HN + (size_t)mn * DM) + FL.lane; tfn = TFLAG[mn];
#pragma unroll
              for (int j = 0; j < 4; ++j) vnb[j] = xr[64 * j]; }
            __builtin_amdgcn_sched_barrier(0);
            f32x4 v[4];
#pragma unroll
            for (int j = 0; j < 4; ++j) v[j] = (f32x4){bflo(vb[j].x), bfhi(vb[j].x), bflo(vb[j].y), bfhi(vb[j].y)};
            f32x4* xw = (f32x4*)(out + (size_t)m * DM) + FL.lane;
            if (__builtin_amdgcn_readfirstlane(tf)) {
#pragma unroll
                for (int j = 0; j < 4; ++j) v[j] = v[j] + xw[64 * j]; }
            float s = 0.f;
#pragma unroll
            for (int j = 0; j < 4; ++j) s += (v[j].x * v[j].x + v[j].y * v[j].y) + (v[j].z * v[j].z + v[j].w * v[j].w);
            const float r = __builtin_amdgcn_rsqf(wave_sum(s) * (1.f / DM) + RMS_EPS);
#pragma unroll
            for (int j = 0; j < 4; ++j) xw[64 * j] = v[j] * r * gv[j];
#pragma unroll
            for (int j = 0; j < 4; ++j) vb[j] = vnb[j];
            tf = tfn;
        }
    }
}

extern "C" void kernel_launch(void* const* d_in, const int* in_sizes, int n_in, void* d_out, int out_size, void* d_ws, size_t ws_size, hipStream_t stream) {
    static int grid = 0;
    if (grid == 0) {
        if (n_in != 20 || in_sizes[0] != T * DM || out_size != T * DM || ws_size < WS_END) { fprintf(stderr, "kernel_launch: unexpected shapes / workspace (%d inputs, ws %zu < %zu)\n", n_in, ws_size, (size_t)WS_END); grid = -1; return; }
        int dev = 0, cus = 0, per_cu = 0;
        if (hipGetDevice(&dev) != hipSuccess || hipDeviceGetAttribute(&cus, hipDeviceAttributeMultiprocessorCount, dev) != hipSuccess) { grid = -1; return; }
        if (hipFuncSetAttribute((const void*)trunk_fwd, hipFuncAttributeMaxDynamicSharedMemorySize, LDS_BYTES) != hipSuccess) { fprintf(stderr, "kernel_launch: hipFuncSetAttribute failed\n"); grid = -1; return; }
        if (hipOccupancyMaxActiveBlocksPerMultiprocessor(&per_cu, (const void*)trunk_fwd, NWAVES * 64, LDS_BYTES) != hipSuccess || per_cu < 1) { fprintf(stderr, "kernel_launch: occupancy query says %d\n", per_cu); }
        (void)hipGetLastError();
        grid = cus;
    }
    if (grid < 0) return;
    (void)hipMemsetAsync((char*)d_ws + WS_CTL, 0, CTL_ZERO_BYTES, stream);
    Args a{};
    for (int i = 0; i < 20; ++i) a.in[i] = d_in[i];
    a.out = (float*)d_out; a.ws = (unsigned char*)d_ws;
    hipLaunchKernelGGL(trunk_fwd, dim3(grid), dim3(NWAVES * 64), LDS_BYTES, stream, a);
}
```

```cpp
#include <hip/hip_runtime.h>
#include <cstdio>
#include <cstdint>

#define LAS __attribute__((address_space(3)))
#define GAS __attribute__((address_space(1)))
typedef unsigned short bf16_t;
typedef short bf16x8 __attribute__((ext_vector_type(8)));
typedef short s16x4 __attribute__((ext_vector_type(4)));
typedef float f32x2 __attribute__((ext_vector_type(2)));
typedef float f32x4 __attribute__((ext_vector_type(4)));
typedef float f32x16 __attribute__((ext_vector_type(16)));
typedef unsigned u32x2 __attribute__((ext_vector_type(2)));
typedef unsigned u32x4 __attribute__((ext_vector_type(4)));
typedef __bf16 bf16x2_t __attribute__((ext_vector_type(2)));
typedef GAS unsigned gu32;

constexpr int BATCH = 2, SEQ = 16384, T = BATCH * SEQ, DM = 1024;
constexpr int QKVC = 4608;
constexpr int DSAW = 512;
constexpr int FF0 = 2816, FFE = 3584, NEXP = 8;
constexpr int MLA_IN = 672, MLA_INP = 768, QL = 384, KVL = 256, NH = 16, HQ = 96, QC = NH * HQ  , KVC = NH * 128  ;
constexpr float RMS_EPS = 1e-6f;
constexpr float LOG2E = 1.4426950408889634f;
constexpr float C2_DSA = 0.125f * LOG2E;
constexpr float C2_MLA = 0.10206207261596575f * LOG2E;
constexpr int MOE_MAXROWS = T + NEXP * 256;
constexpr int NWAVES = 8;
#ifndef MOE_TAIL_SPLIT
#define MOE_TAIL_SPLIT 2
#endif

constexpr size_t MiB = 1u << 20;
constexpr size_t WS_CTL = 0, CTL_ZERO_BYTES = 1 * MiB;
constexpr size_t WS_WQKV = 1 * MiB, WS_WOA = 10 * MiB, WS_WGU0 = 11 * MiB, WS_WD0 = 22 * MiB, WS_WIN = 28 * MiB, WS_WQUP = 30 * MiB, WS_WKVUP = 32 * MiB, WS_WOB = 33 * MiB;
constexpr size_t WS_COS = 35 * MiB, WS_SIN = 37 * MiB, WS_LSE = 39 * MiB, WS_KR = 42 * MiB;
constexpr size_t WS_SSL = 200 * MiB  ;
constexpr size_t WS_SSQ = 39 * MiB  , WS_RS = 46 * MiB  , WS_RSROW = 46 * MiB + 256 * 1024  , WS_TFLAG = 47 * MiB  , WS_XB1 = 292 * MiB  ;
constexpr size_t WS_E01 = 44 * MiB, WS_GWT = WS_E01 + 128 * 1024, WS_LIST = WS_GWT + 256 * 1024, WS_GWS = WS_LIST + 288 * 1024, WS_CNT = WS_GWS + 288 * 1024, WS_BASES = WS_CNT + 16 * 1024;
constexpr size_t WS_HN = 48 * MiB, WS_QKV = 112 * MiB, WS_O3 = 400 * MiB, WS_MIX = 48 * MiB, WS_ACT0 = 112 * MiB;
constexpr size_t WS_MOEGU = 360 * MiB  , WS_HN8 = 428 * MiB  , WS_MOED = 472 * MiB;
constexpr size_t WS_ALAT = 112 * MiB, WS_CQ = 160 * MiB, WS_CKV = 184 * MiB, WS_Q = 48 * MiB, WS_KV = 232 * MiB, WS_O = 144 * MiB, WS_ACTE = 112 * MiB;
constexpr size_t WS_END = 528 * MiB;
static_assert(WS_BASES + 4096 <= 46 * MiB, "routing tables");
static_assert(WS_ACTE + (size_t)MOE_MAXROWS * FFE * 2 <= WS_MOEGU, "moe act");
static_assert(2 * MOE_MAXROWS * 4 <= 288 * 1024, "list size");
constexpr int CW_BAR = 4096;

constexpr int RING_BYTES = 131072;
constexpr int MISC_OFF = 143360;
constexpr int LDS_BYTES = 147456;

#define RLX_AGENT __ATOMIC_RELAXED, __HIP_MEMORY_SCOPE_AGENT
#define LDS_WAIT() asm volatile("s_waitcnt lgkmcnt(0)" ::: "memory")
#define VM_WAIT() asm volatile("s_waitcnt vmcnt(0)" ::: "memory")
__device__ __forceinline__ unsigned f2bf(float f) { unsigned u = __builtin_bit_cast(unsigned, f); return (u + 0x7fffu + ((u >> 16) & 1u)) >> 16; }
__device__ __forceinline__ unsigned pk2(float lo, float hi) { f32x2 v = {lo, hi}; bf16x2_t b = __builtin_convertvector(v, bf16x2_t); return __builtin_bit_cast(unsigned, b); }
__device__ __forceinline__ unsigned pk4_fp8(float a, float b, float c, float d) { int p_ = __builtin_amdgcn_cvt_pk_fp8_f32(a, b, 0, false); p_ = __builtin_amdgcn_cvt_pk_fp8_f32(c, d, p_, true); return (unsigned)p_; }
__device__ __forceinline__ float bf2f(unsigned short h) { return __builtin_bit_cast(float, (unsigned)h << 16); }
__device__ __forceinline__ float bflo(unsigned w) { return __builtin_bit_cast(float, w << 16); }
__device__ __forceinline__ float bfhi(unsigned w) { return __builtin_bit_cast(float, w & 0xffff0000u); }
__device__ __forceinline__ float wave_sum(float v) {
    int x = __builtin_bit_cast(int, v);
    v += __builtin_bit_cast(float, __builtin_amdgcn_update_dpp(0, x, 0xB1, 0xF, 0xF, true));  x = __builtin_bit_cast(int, v);
    v += __builtin_bit_cast(float, __builtin_amdgcn_update_dpp(0, x, 0x4E, 0xF, 0xF, true));  x = __builtin_bit_cast(int, v);
    v += __builtin_bit_cast(float, __builtin_amdgcn_update_dpp(0, x, 0x141, 0xF, 0xF, true)); x = __builtin_bit_cast(int, v);
    v += __builtin_bit_cast(float, __builtin_amdgcn_update_dpp(0, x, 0x140, 0xF, 0xF, true)); x = __builtin_bit_cast(int, v);
    const float r0 = __builtin_bit_cast(float, __builtin_amdgcn_readlane(x, 0)), r1 = __builtin_bit_cast(float, __builtin_amdgcn_readlane(x, 16));
    const float r2 = __builtin_bit_cast(float, __builtin_amdgcn_readlane(x, 32)), r3 = __builtin_bit_cast(float, __builtin_amdgcn_readlane(x, 48));
    return (r0 + r1) + (r2 + r3);
}
__device__ __forceinline__ int lds_add(LAS int* p, int v) { return __hip_atomic_fetch_add(p, v, __ATOMIC_RELAXED, __HIP_MEMORY_SCOPE_WORKGROUP); }
__device__ __forceinline__ float fast_exp2(float x) { return __builtin_amdgcn_exp2f(x); }
__device__ __forceinline__ float fast_rcp(float x) { return __builtin_amdgcn_rcpf(x); }

#define XB_TMO      128
#define XB_XCNT(j)  (256  + 64 * (j))
#define XB_XSUB(j)  (1280 + 64 * (j))
#define XB_XGEN(j)  (2304 + 64 * (j))
#define XB_TOP      3328
#define XB_TOPGEN   3392
#define XCD_BAR_WORDS 3456
#define XB_SPIN_CAP (1u << 18)
__device__ __forceinline__ unsigned xb_ld(unsigned* p)              { return __hip_atomic_load(p, __ATOMIC_RELAXED, __HIP_MEMORY_SCOPE_AGENT); }
__device__ __forceinline__ unsigned xb_add(unsigned* p, unsigned v) { return __hip_atomic_fetch_add(p, v, __ATOMIC_RELAXED, __HIP_MEMORY_SCOPE_AGENT); }
__device__ __forceinline__ unsigned xb_xcc_id() { return (unsigned)__builtin_amdgcn_s_getreg((3 << 11) | 20) & 0xFu; }
#define XB_SPIN(cond, bar) do { unsigned _sp = 0; while (cond) { __builtin_amdgcn_s_sleep(1); \
    if ((++_sp & 255u) == 0u) { if (xb_ld(&(bar)[XB_TMO])) break; if (_sp > XB_SPIN_CAP) { atomicAdd(&(bar)[XB_TMO], 1u); break; } } } } while (0)
struct XcdBarrier { unsigned* bar; unsigned x; volatile LAS unsigned* st; };
__device__ __forceinline__ XcdBarrier xcd_barrier_post(unsigned* bar, volatile LAS unsigned* st) {
    XcdBarrier b; b.bar = bar; b.x = xb_xcc_id(); b.st = st;
    if (threadIdx.x == 0) (void)xb_add(&bar[XB_XCNT(b.x)], 1u);
    return b;
}
__device__ __forceinline__ void xcd_barrier_complete(unsigned* bar, unsigned x, unsigned& nloc, unsigned& nx) {
    const unsigned G = gridDim.x * gridDim.y * gridDim.z;
    unsigned sum, cnt, mine, sp = 0u;
    for (;;) {
        sum = 0u; cnt = 0u; mine = 0u;
#pragma unroll
        for (unsigned j = 0; j < 16; ++j) { const unsigned c = xb_ld(&bar[XB_XCNT(j)]); sum += c; cnt += (c > 0u) ? 1u : 0u; mine = (j == x) ? c : mine; }
        if (sum == G) break;
        __builtin_amdgcn_s_sleep(1);
        if ((++sp & 255u) == 0u) { if (xb_ld(&bar[XB_TMO])) break; if (sp > XB_SPIN_CAP) { atomicAdd(&bar[XB_TMO], 1u); break; } }
    }
    nloc = mine > 0u ? mine : 1u; nx = cnt > 0u ? cnt : 1u;
}
__device__ __forceinline__ void xcd_barrier(const XcdBarrier& b) {
    asm volatile("s_waitcnt vmcnt(0)" ::: "memory");
    __syncthreads();
    if (threadIdx.x == 0) {
        unsigned* bar = b.bar;
        __builtin_amdgcn_s_waitcnt(0);
        unsigned nloc = b.st[0], nx = b.st[1];
        if (nloc == 0u) { xcd_barrier_complete(bar, b.x, nloc, nx); b.st[0] = nloc; b.st[1] = nx; }
        const unsigned old = xb_add(&bar[XB_XSUB(b.x)], 1u);
        const unsigned gen = old / nloc;
        if (old + 1u == (gen + 1u) * nloc) {
            __builtin_amdgcn_fence(__ATOMIC_RELEASE, "agent");
            asm volatile("s_waitcnt vmcnt(0)" ::: "memory");
            const unsigned og = xb_add(&bar[XB_TOP], 1u);
            const unsigned tg = og / nx;
            if (og + 1u == (tg + 1u) * nx) xb_add(&bar[XB_TOPGEN], 1u);
            else XB_SPIN(xb_ld(&bar[XB_TOPGEN]) == tg, bar);
            __builtin_amdgcn_fence(__ATOMIC_ACQUIRE, "agent");
            xb_add(&bar[XB_XGEN(b.x)], 1u);
            asm volatile("s_waitcnt vmcnt(0)" ::: "memory");
        } else {
            XB_SPIN(xb_ld(&bar[XB_XGEN(b.x)]) == gen, bar);
            __builtin_amdgcn_fence(__ATOMIC_ACQUIRE, "agent");
            asm volatile("s_waitcnt vmcnt(0)" ::: "memory");
        }
    }
    __syncthreads();
}

namespace pg {
constexpr int BM = 256, BK = 64, HALF = 128, HTB = HALF * BK * 2, STAGE_BYTES = 8 * HTB, NXCD = 8, WGM = 8;
__host__ __device__ __forceinline__ int lds_byte(int r, int c) { const int st = (r >> 4) * 2 + (c >> 5), rr = r & 15, cc = c & 31, ob = rr * 64 + cc * 2; return st * 1024 + (ob ^ (((ob >> 9) & 1) << 5)); }
__host__ __device__ __forceinline__ void stage_rc(int b, int& R, int& C) { const int st = b / 1024, sb = b % 1024, swz = sb ^ (((sb >> 9) & 1) << 5); R = (st >> 1) * 16 + swz / 64; C = (st & 1) * 32 + (swz % 64) / 2; }
__host__ __device__ __forceinline__ int perm32(int rho) { const int n = rho >> 4, i = rho & 15; return 8 * (i >> 2) + 4 * n + (i & 3); }

struct Unit { int pm, pn; long boff; int koff; };

struct StaticOrder {
    int nM, nN, nwg, G, c;
    __device__ __forceinline__ void init(int M, int N, int G_, int c_) { nM = M / BM; nN = N / BM; nwg = nM * nN; G = G_; c = c_; }
    __device__ __forceinline__ bool next(int i, Unit& u) const {
        const long L = (long)i * G + c; if (L >= nwg) return false;
        int wgid = (int)L; { const int q = nwg / NXCD, r = nwg % NXCD, xcd = wgid % NXCD, off = wgid / NXCD; wgid = (xcd < r ? xcd * (q + 1) : r * (q + 1) + (xcd - r) * q) + off; }
        const int nig = WGM * nN, gid = wgid / nig, fm = gid * WGM, gsz = (nM - fm) < WGM ? (nM - fm) : WGM;
        u.pm = fm + ((wgid % nig) % gsz); u.pn = (wgid % nig) / gsz; u.boff = 0; u.koff = 0; return true;
    }
};
template <int NN, int KSPLIT, long ESTRIDE>
struct MoeOrder {
    static constexpr int nN = NN, ksplit = KSPLIT; static constexpr long estride = ESTRIDE;
    int t0, t1, G, c, klen; int base[NEXP + 1];
    int rd_ntc = 0, rd_R = 1 << 20;
    __device__ __forceinline__ bool next(int i, Unit& u) const {
        const int late = i - rd_R > 0 ? i - rd_R : 0;
        const int L = i * G + c - late * rd_ntc, nwg = (t1 - t0) * nN * ksplit;
        if (L >= nwg || (late > 0 && c < rd_ntc)) return false;
        int ks, pm_, pn_;
        if (ksplit == 1) {
            int wgid = (int)L; { const int q = nwg / NXCD, r = nwg % NXCD, xcd = wgid % NXCD, off = wgid / NXCD; wgid = (xcd < r ? xcd * (q + 1) : r * (q + 1) + (xcd - r) * q) + off; }
            const int nT_ = t1 - t0, nig = WGM * nN, gid = wgid / nig, fm = gid * WGM, gsz = (nT_ - fm) < WGM ? (nT_ - fm) : WGM;
            pm_ = fm + ((wgid % nig) % gsz); pn_ = (wgid % nig) / gsz; ks = 0;
        } else { ks = (int)(L % ksplit); const int r = (int)(L / ksplit); pm_ = r / nN; pn_ = r % nN; }
        u.pm = t0 + pm_; u.pn = pn_; u.koff = ks * klen;
        int e = 0;
#pragma unroll
        for (int k = 1; k < NEXP; ++k) if (u.pm * BM >= base[k]) e = k;
        u.boff = (long)e * estride; return true;
    }
};

typedef f32x4 Acc[2][2][4][2];
typedef float f32x32 __attribute__((ext_vector_type(32)));
typedef f32x32 Acc32[2][2];
__device__ __forceinline__ f32x4 acc4(const Acc& a, int ai, int bj, int m, int n) { return a[ai][bj][m][n]; }
__device__ __forceinline__ f32x4 acc4(const Acc32& a, int ai, int bj, int m, int n) { const int e = (m * 2 + n) * 4; return (f32x4){a[ai][bj][e], a[ai][bj][e + 1], a[ai][bj][e + 2], a[ai][bj][e + 3]}; }

struct EpiQKV {
    static constexpr bool PERM = true;
    bf16_t* O; float scale_q;
    __device__ __forceinline__ void operator()(const Acc& acc, const Unit& u, int wr, int wc, int fr, int fq) const {
        const int gp = u.pn >> 1, g = gp / 3, dsh = 2 * g, hb = (u.pn & 1) * 4;
        const float sc = (gp - 3 * g) == 0 ? scale_q : 1.f;
        const int row0 = u.pm * BM + wr * 64 + fr, d0 = (wc & 1) * 32 + 8 * fq;
#pragma unroll
        for (int ai = 0; ai < 2; ++ai)
#pragma unroll
            for (int m = 0; m < 4; ++m) { const int r = row0 + ai * HALF + m * 16, t = r & (SEQ - 1);
                const size_t rp = (size_t)(r - t) + ((size_t)(t & ((1 << dsh) - 1)) << (14 - dsh)) + (t >> dsh);
#pragma unroll
                for (int bj = 0; bj < 2; ++bj) { const f32x4 v0 = acc[ai][bj][m][0] * sc, v1 = acc[ai][bj][m][1] * sc;
                    u32x4 w; w.x = pk2(v0[0], v0[1]); w.y = pk2(v0[2], v0[3]); w.z = pk2(v1[0], v1[1]); w.w = pk2(v1[2], v1[3]);
                    *(u32x4*)(O + ((size_t)(gp * 8 + hb + 2 * bj + (wc >> 1)) * T + rp) * 64 + d0) = w; } }
    }
};
static_assert(SEQ == (1 << 14), "residue-major row arithmetic assumes SEQ = 2^14");
__device__ __forceinline__ float quad_col_sum(float s) {
    s += __builtin_bit_cast(float, __builtin_amdgcn_ds_swizzle(__builtin_bit_cast(int, s), 0x401F));
    return s + __builtin_bit_cast(float, __builtin_amdgcn_ds_bpermute((int)((threadIdx.x ^ 32u) << 2), __builtin_bit_cast(int, s)));
}
template <bool F32RES, bool F32OUT>
struct EpiResBf {
    static constexpr bool PERM = true;
    const void* res; float* out; bf16_t* xb; float* ssq;
    __device__ __forceinline__ void operator()(const Acc& acc, const Unit& u, int wr, int wc, int fr, int fq) const {
        const int col0 = u.pn * BM + wc * 32 + 8 * fq;
#pragma unroll
        for (int ai = 0; ai < 2; ++ai)
#pragma unroll
            for (int m = 0; m < 4; ++m) { const int row = u.pm * BM + ai * HALF + wr * 64 + m * 16 + fr; const size_t off = (size_t)row * DM + col0; float sq = 0.f;
#pragma unroll
                for (int bj = 0; bj < 2; ++bj) {
                    f32x4 v0, v1;
                    if (F32RES) { v0 = *(const f32x4*)((const float*)res + off + bj * HALF); v1 = *(const f32x4*)((const float*)res + off + bj * HALF + 4); }
                    else { const u32x4 rw = *(const u32x4*)((const bf16_t*)res + off + bj * HALF); v0 = (f32x4){bflo(rw.x), bfhi(rw.x), bflo(rw.y), bfhi(rw.y)}; v1 = (f32x4){bflo(rw.z), bfhi(rw.z), bflo(rw.w), bfhi(rw.w)}; }
                    v0 = v0 + acc[ai][bj][m][0]; v1 = v1 + acc[ai][bj][m][1];
                    if (F32OUT) { *(f32x4*)(out + off + bj * HALF) = v0; *(f32x4*)(out + off + bj * HALF + 4) = v1; }
                    sq += (v0[0] * v0[0] + v0[1] * v0[1]) + (v0[2] * v0[2] + v0[3] * v0[3]) + (v1[0] * v1[0] + v1[1] * v1[1]) + (v1[2] * v1[2] + v1[3] * v1[3]);
                    u32x4 w; w.x = pk2(v0[0], v0[1]); w.y = pk2(v0[2], v0[3]); w.z = pk2(v1[0], v1[1]); w.w = pk2(v1[2], v1[3]);
                    *(u32x4*)(xb + off + bj * HALF) = w; }
                sq = quad_col_sum(sq);
                if (fq == 0) ssq[(size_t)row * 16 + 4 * u.pn + wc] = sq; }
    }
};
__device__ __forceinline__ float row_rrms(const float* ssq, int row) {
    const f32x4* p = (const f32x4*)(ssq + (size_t)row * 16); const f32x4 a = p[0], b = p[1], c = p[2], d = p[3];
    const float t = (((a[0] + a[1]) + (a[2] + a[3])) + ((b[0] + b[1]) + (b[2] + b[3]))) + (((c[0] + c[1]) + (c[2] + c[3])) + ((d[0] + d[1]) + (d[2] + d[3])));
    return __builtin_amdgcn_rsqf(t * (1.f / DM) + RMS_EPS);
}
template <int Q0, int NQ>
__device__ __forceinline__ float slot_rrms(const float* ssl, int row, float inv_n) {
    const f32x4* p = (const f32x4*)(ssl + (size_t)row * 32) + Q0; float t = 0.f;
#pragma unroll
    for (int q = 0; q < NQ; ++q) { const f32x4 a = p[q]; t += (a[0] + a[1]) + (a[2] + a[3]); }
    return __builtin_amdgcn_rsqf(t * inv_n + RMS_EPS);
}
struct EpiLat {
    static constexpr bool PERM = true;
    bf16_t* cq; bf16_t* ckv; bf16_t* kr; const float* ssq; float* ssl; const float* cs; const float* sn;
    __device__ __forceinline__ void operator()(const Acc& acc, const Unit& u, int wr, int wc, int fr, int fq) const {
        const int row0 = u.pm * BM + wr * 64 + fr;
#pragma unroll
        for (int ai = 0; ai < 2; ++ai)
#pragma unroll
            for (int m = 0; m < 4; ++m) { const int row = row0 + ai * HALF + m * 16; const float sc = row_rrms(ssq, row);
#pragma unroll
                for (int bj = 0; bj < 2; ++bj) { const int cb = u.pn * BM + bj * HALF;
                    const f32x4 v0 = acc[ai][bj][m][0] * sc, v1 = acc[ai][bj][m][1] * sc;
                    if (cb < QL + KVL) {
                        u32x4 w; w.x = pk2(v0[0], v0[1]); w.y = pk2(v0[2], v0[3]); w.z = pk2(v1[0], v1[1]); w.w = pk2(v1[2], v1[3]);
                        bf16_t* dst = cb < QL ? cq + (size_t)row * QL + cb : ckv + (size_t)row * KVL + (cb - QL);
                        *(u32x4*)(dst + wc * 32 + 8 * fq) = w;
                        float sq = (v0[0] * v0[0] + v0[1] * v0[1]) + (v0[2] * v0[2] + v0[3] * v0[3]) + (v1[0] * v1[0] + v1[1] * v1[1]) + (v1[2] * v1[2] + v1[3] * v1[3]);
                        sq = quad_col_sum(sq);
                        if (fq == 0) ssl[(size_t)row * 32 + (cb >> 7) * 4 + wc] = sq;
                    } else if (cb == QL + KVL && wc == 0) {
                        const f32x4 c = *(const f32x4*)(cs + (size_t)row * 16 + 4 * fq), s_ = *(const f32x4*)(sn + (size_t)row * 16 + 4 * fq);
                        u32x4 w; w.x = pk2(v0[0] * c[0] - v0[1] * s_[0], v0[0] * s_[0] + v0[1] * c[0]); w.y = pk2(v0[2] * c[1] - v0[3] * s_[1], v0[2] * s_[1] + v0[3] * c[1]);
                        w.z = pk2(v1[0] * c[2] - v1[1] * s_[2], v1[0] * s_[2] + v1[1] * c[2]); w.w = pk2(v1[2] * c[3] - v1[3] * s_[3], v1[2] * s_[3] + v1[3] * c[3]);
                        *(u32x4*)(kr + (size_t)row * 32 + 8 * fq) = w; } } }
    }
};
struct EpiKVScale {
    static constexpr bool PERM = true;
    bf16_t* O; int ldc; const float* ssl;
    __device__ __forceinline__ void operator()(const Acc& acc, const Unit& u, int wr, int wc, int fr, int fq) const {
        const int row0 = u.pm * BM + wr * 64 + fr, col0 = u.pn * BM + wc * 32 + 8 * fq;
#pragma unroll
        for (int ai = 0; ai < 2; ++ai)
#pragma unroll
            for (int m = 0; m < 4; ++m) { const int row = row0 + ai * HALF + m * 16; const float sc = slot_rrms<3, 2>(ssl, row, 1.f / KVL); bf16_t* rowp = O + (size_t)row * ldc + col0;
#pragma unroll
                for (int bj = 0; bj < 2; ++bj) { const f32x4 v0 = acc[ai][bj][m][0] * sc, v1 = acc[ai][bj][m][1] * sc;
                    u32x4 w; w.x = pk2(v0[0], v0[1]); w.y = pk2(v0[2], v0[3]); w.z = pk2(v1[0], v1[1]); w.w = pk2(v1[2], v1[3]);
                    *(u32x4*)(rowp + bj * HALF) = w; } }
    }
};
template <int RS, bool OUT8 = false>
struct EpiSwiGLUT {
    static constexpr bool PERM = true;
    bf16_t* O; int ldc; const float* rs;
    template <class AccT>
    __device__ __forceinline__ void operator()(const AccT& acc, const Unit& u, int wr, int wc, int fr, int fq) const {
        const int row0 = u.pm * BM + wr * 64 + fr, col0 = u.pn * HALF + wc * 32 + 8 * fq;
        float rrv[8];
#pragma unroll
        for (int i = 0; i < 8; ++i) rrv[i] = RS ? rs[row0 + (i >> 2) * HALF + (i & 3) * 16] : 1.f;
        if (RS) __builtin_amdgcn_sched_barrier(0);
#pragma unroll
        for (int ai = 0; ai < 2; ++ai)
#pragma unroll
            for (int m = 0; m < 4; ++m) { float o[8]; const float rr = rrv[ai * 4 + m];
                const float c1 = -rr * LOG2E, kk = fast_rcp(rr * rr * (OUT8 ? 8.f : 1.f));
#pragma unroll
                for (int n = 0; n < 2; ++n) { const f32x4 ag = acc4(acc, ai, 0, m, n), au = acc4(acc, ai, 1, m, n);
#pragma unroll
                    for (int j = 0; j < 4; ++j) o[4 * n + j] = (ag[j] * au[j]) * fast_rcp(__builtin_fmaf(fast_exp2(ag[j] * c1), kk, kk)); }
                if (OUT8) {
#pragma unroll
                    for (int q = 0; q < 8; ++q) o[q] = __builtin_amdgcn_fmed3f(o[q], -448.f, 448.f);
                    u32x2 w8; w8.x = pk4_fp8(o[0], o[1], o[2], o[3]); w8.y = pk4_fp8(o[4], o[5], o[6], o[7]);
                    *(u32x2*)((unsigned char*)O + (size_t)(row0 + ai * HALF + m * 16) * ldc + col0) = w8; }
                else { u32x4 w; w.x = pk2(o[0], o[1]); w.y = pk2(o[2], o[3]); w.z = pk2(o[4], o[5]); w.w = pk2(o[6], o[7]);
                    *(u32x4*)(O + (size_t)(row0 + ai * HALF + m * 16) * ldc + col0) = w; } }
    }
};
typedef EpiSwiGLUT<1, true> EpiSwiGLU;
struct EpiQRope {
    static constexpr bool PERM = true;
    bf16_t* O; const float* cs; const float* sn; const float* ssl;
    __device__ __forceinline__ void operator()(const Acc& acc, const Unit& u, int wr, int wc, int fr, int fq) const {
        const int row0 = u.pm * BM + wr * 64 + fr;
#pragma unroll
        for (int ai = 0; ai < 2; ++ai)
#pragma unroll
            for (int m = 0; m < 4; ++m) { const int row = row0 + ai * HALF + m * 16; const float qs = C2_MLA * slot_rrms<0, 3>(ssl, row, 1.f / QL);
#pragma unroll
                for (int bj = 0; bj < 2; ++bj) { const int c0 = u.pn * BM + bj * HALF + wc * 32 + 8 * fq; const int cc = c0 % HQ;
                    f32x4 v0 = acc[ai][bj][m][0], v1 = acc[ai][bj][m][1];
                    if (cc >= 64) { const int i0 = (cc - 64) >> 1;
                        const f32x4 c = *(const f32x4*)(cs + (size_t)row * 16 + i0), s = *(const f32x4*)(sn + (size_t)row * 16 + i0);
                        const f32x4 a = v0, b = v1;
                        v0[0] = a[0] * c[0] - a[1] * s[0]; v0[1] = a[0] * s[0] + a[1] * c[0]; v0[2] = a[2] * c[1] - a[3] * s[1]; v0[3] = a[2] * s[1] + a[3] * c[1];
                        v1[0] = b[0] * c[2] - b[1] * s[2]; v1[1] = b[0] * s[2] + b[1] * c[2]; v1[2] = b[2] * c[3] - b[3] * s[3]; v1[3] = b[2] * s[3] + b[3] * c[3]; }
                    v0 = v0 * qs; v1 = v1 * qs;
                    u32x4 w; w.x = pk2(v0[0], v0[1]); w.y = pk2(v0[2], v0[3]); w.z = pk2(v1[0], v1[1]); w.w = pk2(v1[2], v1[3]);
                    *(u32x4*)(O + (size_t)row * QC + c0) = w; } }
    }
};
struct EpiMoeDown {
    static constexpr bool PERM = false;
    bf16_t* xb; const int* list; const float* gws;
    template <class AccT>
    __device__ __forceinline__ void operator()(const AccT& acc, const Unit& u, int wr, int wc, int fr, int fq) const {
        const int col0 = u.pn * BM + wc * 32 + 4 * fq;
#pragma unroll
        for (int ai = 0; ai < 2; ++ai)
#pragma unroll
            for (int m = 0; m < 4; ++m) { const int r = u.pm * BM + ai * HALF + wr * 64 + m * 16 + fr; const int tok = list[r]; const float w = gws[r];
                if (tok >= 0) { bf16_t* p = xb + (size_t)tok * DM + col0;
#pragma unroll
                    for (int bj = 0; bj < 2; ++bj)
#pragma unroll
                        for (int n = 0; n < 2; ++n) { const u32x2 bw = *(const u32x2*)(p + bj * HALF + n * 16);
                            const f32x4 v = (f32x4){bflo(bw.x), bfhi(bw.x), bflo(bw.y), bfhi(bw.y)} + acc4(acc, ai, bj, m, n) * w;
                            u32x2 o; o.x = pk2(v[0], v[1]); o.y = pk2(v[2], v[3]); *(u32x2*)(p + bj * HALF + n * 16) = o; } } }
    }
};

struct EpiMoeDownAtomic {
    static constexpr bool PERM = false;
    float* out; const int* list; const float* gws;
    template <class AccT>
    __device__ __forceinline__ void operator()(const AccT& acc, const Unit& u, int wr, int wc, int fr, int fq) const {
        const int col0 = u.pn * BM + wc * 32 + 4 * fq;
#pragma unroll
        for (int ai = 0; ai < 2; ++ai)
#pragma unroll
            for (int m = 0; m < 4; ++m) { const int r = u.pm * BM + ai * HALF + wr * 64 + m * 16 + fr; const int tok = list[r]; const float w = gws[r];
                if (tok >= 0) { float* p = out + (size_t)tok * DM + col0;
#pragma unroll
                    for (int bj = 0; bj < 2; ++bj)
#pragma unroll
                        for (int n = 0; n < 2; ++n) { const f32x4 av = acc4(acc, ai, bj, m, n);
#pragma unroll
                            for (int j = 0; j < 4; ++j) (void)__hip_atomic_fetch_add(p + bj * HALF + n * 16 + j, av[j] * w, __ATOMIC_RELAXED, __HIP_MEMORY_SCOPE_AGENT); } } }
    }
};

typedef int v8i32_t __attribute__((ext_vector_type(8)));
typedef int v4i32_t __attribute__((ext_vector_type(4)));
template <bool C, class A_, class B_> struct Sel { typedef A_ type; };
template <class A_, class B_> struct Sel<false, A_, B_> { typedef B_ type; };
template <class Epi, class Sched, bool GATHER, bool FP8 = false, int SCALE_A = 127, int SCALE_B = 127>
__device__ __forceinline__ void gemm_phase(LAS unsigned char* lds, const bf16_t* A, const bf16_t* Bt, const int Kc, const int ldc_, const int* list, const Sched& S, const Epi& E) {
    int K = Kc; asm volatile("" : "+s"(K));
    int LD = ldc_; asm volatile("" : "+s"(LD));
    int tid = threadIdx.x; asm volatile("" : "+v"(tid));
    const int wid = __builtin_amdgcn_readfirstlane(tid >> 6), lane = tid & 63, wr = wid >> 2, wc = wid & 3, fr = lane & 15, fq = lane >> 4;
    const int nt = K / BK;
    unsigned voffA[2], voffB[2];
#pragma unroll
    for (int i = 0; i < 2; ++i) { int R, C; stage_rc(tid * 16 + i * 8192, R, C); const int Rb = Epi::PERM ? ((R & ~31) + perm32(R & 31)) : R; voffA[i] = (unsigned)(R * LD + C) * 2u; voffB[i] = (unsigned)(Rb * LD + C) * 2u; }
    const size_t kstep = (size_t)(BK * 2);
    const size_t hstep = (size_t)HALF * LD * 2;
    const size_t tstep = 2 * hstep;
    const unsigned ldsw = (unsigned)wid * 1024u;
    const int aoff = lds_byte(wr * 64 + fr, fq * 8), boff = lds_byte(wc * 32 + fr, fq * 8);
    const char* A8 = (const char*)A;
#define PG_SA(b, h) (((b) * 2 + (h)) * HTB)
#define PG_SB(b, h) ((4 + (b) * 2 + (h)) * HTB)
#define PG_GLDS(src, bufoff, i_) __builtin_amdgcn_global_load_lds((const unsigned*)(src), (LAS unsigned*)(lds + (bufoff) + ldsw + (i_) * 8192), 16, 0, 0)
#define PG_STAGE_B(bufoff, gbase) do { _Pragma("unroll") for (int _i = 0; _i < 2; ++_i) PG_GLDS((const char*)(gbase) + voffB[_i], bufoff, _i); } while (0)
#define PG_STAGE_A(bufoff, CUR, h, kb) do { _Pragma("unroll") for (int _i = 0; _i < 2; ++_i) { \
        if constexpr (GATHER) PG_GLDS(((CUR) ? cA : nA) + (kb) + ((CUR) ? vaC[h][_i] : vaN[h][_i]), bufoff, _i); \
        else PG_GLDS(((CUR) ? cA : nA) + (size_t)(h) * hstep + (kb) + voffA[_i], bufoff, _i); } } while (0)
#define PG_LD1(D_, ADDR_) do { if constexpr (FP8) { const v4i32_t lo_ = *(const LAS v4i32_t*)(ADDR_), hi_ = *(const LAS v4i32_t*)((ADDR_) + 1024); D_ = __builtin_shufflevector(lo_, hi_, 0, 1, 2, 3, 4, 5, 6, 7); } \
        else { D_[0] = *(const LAS bf16x8*)(ADDR_); D_[1] = *(const LAS bf16x8*)((ADDR_) + 1024); } } while (0)
#define PG_LDA(dst, b, h) do { _Pragma("unroll") for (int m = 0; m < 4; ++m) PG_LD1(dst[m], lds + PG_SA(b, h) + aoff + m * 2048); } while (0)
#define PG_LDB(dst, b, h) do { _Pragma("unroll") for (int n = 0; n < 2; ++n) PG_LD1(dst[n], lds + PG_SB(b, h) + boff + n * 2048); } while (0)
#define PG_MMA(ai, bj, At, Bq) do { __builtin_amdgcn_s_setprio(1); _Pragma("unroll") for (int m = 0; m < 4; ++m) _Pragma("unroll") for (int n = 0; n < 2; ++n) { \
        if constexpr (FP8) { f32x4 c_; _Pragma("unroll") for (int j_ = 0; j_ < 4; ++j_) c_[j_] = acc[ai][bj][(m * 2 + n) * 4 + j_]; \
            asm volatile("v_mfma_f32_16x16x128_f8f6f4 %0, %1, %2, %0" : "+v"(c_) : "v"(Bq[n]), "v"(At[m])); \
            _Pragma("unroll") for (int j_ = 0; j_ < 4; ++j_) acc[ai][bj][(m * 2 + n) * 4 + j_] = c_[j_]; } \
        else { _Pragma("unroll") for (int k = 0; k < 2; ++k) acc[ai][bj][m][n] = __builtin_amdgcn_mfma_f32_16x16x32_bf16(Bq[n][k], At[m][k], acc[ai][bj][m][n], 0, 0, 0); } } \
        __builtin_amdgcn_s_setprio(0); } while (0)
#define PG_WAIT_V(n) asm volatile("s_waitcnt vmcnt(" #n ")" ::: "memory")
#define PG_WAIT_L(n) asm volatile("s_waitcnt lgkmcnt(" #n ")" ::: "memory")
#define PG_BAR __builtin_amdgcn_s_barrier()
#define PG_SCHED __builtin_amdgcn_sched_barrier(0)
#define PG_LOAD_VA(dst, U) do { _Pragma("unroll") for (int _h = 0; _h < 2; ++_h) _Pragma("unroll") for (int _i = 0; _i < 2; ++_i) { int _R, _C; stage_rc(tid * 16 + _i * 8192, _R, _C); \
        int _r = list[(U).pm * BM + _h * HALF + _R]; _r = _r < 0 ? 0 : _r; dst[_h][_i] = (unsigned)_r * (unsigned)(LD * 2) + (unsigned)(_C * 2); } } while (0)
    Unit cur, nxt; int ui = 0;
    if (!S.next(0, cur)) return;
    typename Sel<FP8, Acc32, Acc>::type acc;
#define PG_ZERO_ACC() do { _Pragma("unroll") for (int a = 0; a < 2; ++a) _Pragma("unroll") for (int b = 0; b < 2; ++b) { \
        if constexpr (FP8) { _Pragma("unroll") for (int e_ = 0; e_ < 32; ++e_) acc[a][b][e_] = 0.f; } \
        else { _Pragma("unroll") for (int m = 0; m < 4; ++m) _Pragma("unroll") for (int n = 0; n < 2; ++n) acc[a][b][m][n] = (f32x4){0.f, 0.f, 0.f, 0.f}; } } } while (0)
    PG_ZERO_ACC();
    typename Sel<FP8, v8i32_t[4], bf16x8[4][2]>::type At; typename Sel<FP8, v8i32_t[2], bf16x8[2][2]>::type B0, B1;
    unsigned vaC[2][2], vaN[2][2];
    if constexpr (GATHER) { PG_LOAD_VA(vaC, cur); }
    const char* cA = A8 + (GATHER ? 0 : (size_t)cur.pm * tstep) + (size_t)cur.koff * 2; const char* nA = cA;
    const char* cB = (const char*)(Bt + cur.boff + cur.koff) + (size_t)cur.pn * tstep;
    PG_STAGE_B(PG_SB(0, 0), cB); PG_STAGE_B(PG_SB(0, 1), cB + hstep); PG_STAGE_A(PG_SA(0, 0), true, 0, 0); PG_STAGE_A(PG_SA(0, 1), true, 1, 0);
    if (wr == 1) PG_BAR;
    PG_WAIT_V(2); PG_BAR;
    PG_STAGE_B(PG_SB(1, 0), cB + kstep); PG_STAGE_A(PG_SA(1, 0), true, 0, kstep); PG_STAGE_B(PG_SB(1, 1), cB + hstep + kstep);
    PG_WAIT_V(6); PG_BAR;
    for (;;) {
        const bool has_next = S.next(ui + 1, nxt);
        const char* nB = has_next ? (const char*)(Bt + nxt.boff + nxt.koff) + (size_t)nxt.pn * tstep : cB;
        nA = has_next ? A8 + (GATHER ? 0 : (size_t)nxt.pm * tstep) + (size_t)nxt.koff * 2 : cA;
        if constexpr (GATHER) {
            if (has_next) { PG_LOAD_VA(vaN, nxt); }
            else {
#pragma unroll
                for (int h = 0; h < 2; ++h)
#pragma unroll
                    for (int i = 0; i < 2; ++i) vaN[h][i] = vaC[h][i]; }
        }
        for (int t = 0; t < nt; t += 2) {
            const bool last = (t == nt - 2);
            const size_t a1k = (size_t)(t + 1) * kstep;
            const size_t a2k = last ? 0 : (size_t)(t + 2) * kstep; const size_t a3k = a2k + kstep;
            const char* b2 = last ? nB : cB + (size_t)(t + 2) * kstep; const char* b3 = b2 + kstep;
            PG_LDB(B0, 0, 0); PG_LDB(B1, 0, 1); PG_SCHED; PG_LDA(At, 0, 0); PG_STAGE_A(PG_SA(1, 1), true, 1, a1k);
            PG_WAIT_V(8); PG_WAIT_L(0); PG_BAR; PG_MMA(0, 0, At, B0); PG_MMA(0, 1, At, B1); PG_BAR; PG_SCHED;
            PG_LDA(At, 0, 1); PG_STAGE_B(PG_SB(0, 0), b2); PG_STAGE_B(PG_SB(0, 1), b2 + hstep); PG_STAGE_A(PG_SA(0, 0), !last, 0, a2k);
            PG_WAIT_V(8); PG_WAIT_L(0); PG_BAR; PG_MMA(1, 0, At, B0); PG_MMA(1, 1, At, B1); PG_BAR; PG_SCHED;
            PG_LDB(B0, 1, 0); PG_LDB(B1, 1, 1); PG_SCHED; PG_LDA(At, 1, 0); PG_STAGE_A(PG_SA(0, 1), !last, 1, a2k);
            PG_WAIT_V(8); PG_WAIT_L(0); PG_BAR; PG_MMA(0, 0, At, B0); PG_MMA(0, 1, At, B1); PG_BAR; PG_SCHED;
            PG_LDA(At, 1, 1); PG_STAGE_B(PG_SB(1, 0), b3); PG_STAGE_B(PG_SB(1, 1), b3 + hstep); PG_STAGE_A(PG_SA(1, 0), !last, 0, a3k);
            PG_WAIT_V(8); PG_WAIT_L(0); PG_BAR; PG_MMA(1, 0, At, B0); PG_MMA(1, 1, At, B1); PG_BAR; PG_SCHED;
        }
        if (wr == 0) PG_BAR;
        if constexpr (FP8) asm volatile("s_nop 15\n\ts_nop 15" ::: "memory");
        E(acc, cur, wr, wc, fr, fq);
        if (!has_next) break;
        PG_ZERO_ACC();
        cur = nxt; cB = nB; cA = nA; ++ui;
        if constexpr (GATHER) {
#pragma unroll
            for (int h = 0; h < 2; ++h)
#pragma unroll
                for (int i = 0; i < 2; ++i) vaC[h][i] = vaN[h][i]; }
        if (wr == 1) PG_BAR;
    }
    PG_WAIT_V(0);
    PG_BAR;
#undef PG_SA
#undef PG_SB
#undef PG_GLDS
#undef PG_STAGE_A
#undef PG_STAGE_B
#undef PG_LD1
#undef PG_ZERO_ACC
#undef PG_LDA
#undef PG_LDB
#undef PG_MMA
#undef PG_WAIT_V
#undef PG_WAIT_L
#undef PG_BAR
#undef PG_SCHED
#undef PG_LOAD_VA
}
}

namespace att {
typedef short v4i16_t __attribute__((ext_vector_type(4)));
__device__ __forceinline__ int crow(int r, int hi) { return (r & 3) + 8 * (r >> 2) + 4 * hi; }
#define ATT_WAIT_BAR(N) asm volatile("s_waitcnt vmcnt(" #N ") lgkmcnt(0)\n\ts_barrier" ::: "memory")
__device__ __forceinline__ void glds16(const void* gsrc, unsigned lds_dst) { unsigned keep;
    asm volatile("s_mov_b32 %0, m0\n\ts_mov_b32 m0, %2\n\ts_nop 0\n\tglobal_load_lds_dwordx4 %1, off\n\ts_mov_b32 m0, %0" : "=&s"(keep) : "v"(gsrc), "s"(lds_dst) : "memory"); }
__device__ __forceinline__ unsigned lds_addr(const LAS unsigned char* p) { return (unsigned)(uintptr_t)p; }
template <int NKS>
__device__ __forceinline__ void qkt(f32x16& p0, f32x16& p1, const LAS unsigned char* Kslot, const bf16x8 (&qr)[NKS], int r32, int hi) {
    const LAS unsigned char* kb = Kslot + hi * 1024 + r32 * 16;
    f32x16 z;
#pragma unroll
    for (int r = 0; r < 16; ++r) z[r] = 0.f;
    p0 = z; p1 = z;
#pragma unroll
    for (int d0 = 0; d0 < NKS; ++d0) {
        const bf16x8 b0 = *(const LAS bf16x8*)(kb + d0 * 2048);
        const bf16x8 b1 = *(const LAS bf16x8*)(kb + d0 * 2048 + 512);
        p0 = __builtin_amdgcn_mfma_f32_32x32x16_bf16(b0, qr[d0], p0, 0, 0, 0);
        p1 = __builtin_amdgcn_mfma_f32_32x32x16_bf16(b1, qr[d0], p1, 0, 0, 0);
    }
}
__device__ __forceinline__ void softmax_step(f32x16& p0, f32x16& p1, float& m_run, float& l_run, f32x16 (&o)[2], LAS float* wsf, int r32, int hi) {
    float rm = fmaxf(p0[0], p1[0]);
#pragma unroll
    for (int r = 1; r < 16; ++r) rm = fmaxf(rm, fmaxf(p0[r], p1[r]));
    { auto rr = __builtin_amdgcn_permlane32_swap(__float_as_uint(rm), __float_as_uint(rm), false, false); rm = fmaxf(__uint_as_float(rr[0]), __uint_as_float(rr[1])); }
    const float m_new = fmaxf(m_run, rm);
    const float alpha = fast_exp2(m_run - m_new);
    float s = 0.f;
#pragma unroll
    for (int r = 0; r < 16; ++r) { p0[r] = fast_exp2(p0[r] - m_new); p1[r] = fast_exp2(p1[r] - m_new); s += p0[r] + p1[r]; }
    l_run = l_run * alpha + s;
    const bool need = __any(m_new > m_run);
    m_run = m_new;
    if (need) {
        if (hi == 0) wsf[r32] = alpha;
        LDS_WAIT();
#pragma unroll
        for (int r = 0; r < 16; ++r) { const float f = wsf[crow(r, hi)]; o[0][r] *= f; o[1][r] *= f; }
        LDS_WAIT();
    }
}
__device__ __forceinline__ void pv_step(f32x16 (&o)[2], const f32x16& p0, const f32x16& p1, const LAS unsigned char* Vslot, int lane, int hi) {
    u32x4 pw[4];
    pw[0] = (u32x4){pk2(p0[0], p0[1]), pk2(p0[2], p0[3]), pk2(p0[4], p0[5]), pk2(p0[6], p0[7])};
    pw[1] = (u32x4){pk2(p0[8], p0[9]), pk2(p0[10], p0[11]), pk2(p0[12], p0[13]), pk2(p0[14], p0[15])};
    pw[2] = (u32x4){pk2(p1[0], p1[1]), pk2(p1[2], p1[3]), pk2(p1[4], p1[5]), pk2(p1[6], p1[7])};
    pw[3] = (u32x4){pk2(p1[8], p1[9]), pk2(p1[10], p1[11]), pk2(p1[12], p1[13]), pk2(p1[14], p1[15])};
    const LAS unsigned char* vb = Vslot + ((lane >> 4) & 1) * 32 + (lane & 3) * 8 + (4 * hi + ((lane & 15) >> 2)) * 64;
#pragma unroll
    for (int d0 = 0; d0 < 2; ++d0)
#pragma unroll
        for (int ks = 0; ks < 4; ++ks) {
            const s16x4 lo = __builtin_bit_cast(s16x4, __builtin_amdgcn_ds_read_tr16_b64_v4i16((LAS v4i16_t*)(vb + d0 * 4096 + ks * 1024)));
            const s16x4 hh = __builtin_bit_cast(s16x4, __builtin_amdgcn_ds_read_tr16_b64_v4i16((LAS v4i16_t*)(vb + d0 * 4096 + ks * 1024 + 512)));
            const bf16x8 vf = (bf16x8){lo[0], lo[1], lo[2], lo[3], hh[0], hh[1], hh[2], hh[3]};
            o[d0] = __builtin_amdgcn_mfma_f32_32x32x16_bf16(__builtin_bit_cast(bf16x8, pw[ks]), vf, o[d0], 0, 0, 0);
        }
}
__device__ __forceinline__ float finish_rows(f32x16 (&o)[2], float l_run, LAS float* wsf, LAS bf16_t* stg, int r32, int hi) {
    const float l = l_run + __shfl_xor(l_run, 32);
    if (hi == 0) wsf[32 + r32] = l;
    LDS_WAIT();
#pragma unroll
    for (int r = 0; r < 16; ++r) { const int orow = crow(r, hi); const float rl = fast_rcp(wsf[32 + orow]);
#pragma unroll
        for (int d0 = 0; d0 < 2; ++d0) stg[orow * 64 + d0 * 32 + r32] = (bf16_t)f2bf(o[d0][r] * rl); }
    LDS_WAIT();
    return l;
}
}

struct Args { const void* in[20]; float* out; unsigned char* ws; };

struct Frame {
    LAS unsigned char* lds;
    int tid, lane, wave, G, bid;
};
__device__ __forceinline__ Frame phase_frame(const Frame& F) { Frame P = F; asm volatile("" : "+v"(P.tid)); P.lane = P.tid & 63; return P; }

__device__ __forceinline__ void tr_item(const float* __restrict__ W, int ldw, int k0, int scol, bf16_t* WT, int K, int drow0, LAS float* scr, int lane, const float* gain = nullptr) {
#pragma unroll 8
    for (int i = 0; i < 32; ++i) { const int kk = 2 * i + (lane >> 5); scr[kk * 33 + (lane & 31)] = scol >= 0 ? W[(size_t)(k0 + kk) * ldw + scol] * (gain ? gain[k0 + kk] : 1.f) : 0.f; }
    LDS_WAIT(); asm volatile("" ::: "memory");
    const int c = lane & 7;
#pragma unroll
    for (int j = 0; j < 4; ++j) { const int n = (lane >> 3) + 8 * j; const LAS float* s = scr + (8 * c) * 33 + n;
        u32x4 o; o.x = pk2(s[0 * 33], s[1 * 33]); o.y = pk2(s[2 * 33], s[3 * 33]); o.z = pk2(s[4 * 33], s[5 * 33]); o.w = pk2(s[6 * 33], s[7 * 33]);
        *(u32x4*)(WT + (size_t)(drow0 + n) * K + k0 + 8 * c) = o; }
    LDS_WAIT(); asm volatile("" ::: "memory");
}
template <bool GAIN = false, bool FP8 = false>
__device__ __forceinline__ void tr_item64(const float* __restrict__ W, int ldw, int k0, int scol0, bf16_t* WT, int K, int drow0, LAS unsigned char* scr, int lane, const float* gain = nullptr) {
    const int kr = lane >> 4, nq = lane & 15;
    const float* src = W + (size_t)(k0 + kr) * ldw + scol0 + 4 * nq;
    f32x4 v[16];
#pragma unroll
    for (int i = 0; i < 16; ++i) v[i] = __builtin_nontemporal_load((const f32x4*)(src + (size_t)(4 * i) * ldw));
    if (GAIN) {
#pragma unroll
        for (int i = 0; i < 16; ++i) v[i] = v[i] * gain[k0 + kr + 4 * i]; }
#pragma unroll
    for (int i = 0; i < 16; ++i) { u32x2 w; w.x = pk2(v[i].x, v[i].y); w.y = pk2(v[i].z, v[i].w); *(LAS u32x2*)(scr + (4 * i + kr) * 192 + nq * 8) = w; }
    LDS_WAIT(); asm volatile("" ::: "memory");
    const int g = lane >> 4;
    const LAS unsigned char* rb = scr + ((lane & 15) >> 2) * 192 + g * 32 + (lane & 3) * 8;
    bf16_t* dst = WT + (size_t)(drow0 + 16 * g + (lane & 15)) * K + k0;
    unsigned char* dst8 = (unsigned char*)WT + (size_t)(drow0 + 16 * g + (lane & 15)) * K + k0;
#pragma unroll
    for (int kc = 0; kc < 8; ++kc) {
        const s16x4 lo = __builtin_bit_cast(s16x4, __builtin_amdgcn_ds_read_tr16_b64_v4i16((LAS att::v4i16_t*)(rb + (8 * kc) * 192)));
        const s16x4 hh = __builtin_bit_cast(s16x4, __builtin_amdgcn_ds_read_tr16_b64_v4i16((LAS att::v4i16_t*)(rb + (8 * kc + 4) * 192)));
        if (FP8) { u32x2 w8;
            w8.x = pk4_fp8(bf2f((unsigned short)lo[0]) * 64.f, bf2f((unsigned short)lo[1]) * 64.f, bf2f((unsigned short)lo[2]) * 64.f, bf2f((unsigned short)lo[3]) * 64.f);
            w8.y = pk4_fp8(bf2f((unsigned short)hh[0]) * 64.f, bf2f((unsigned short)hh[1]) * 64.f, bf2f((unsigned short)hh[2]) * 64.f, bf2f((unsigned short)hh[3]) * 64.f);
            *(u32x2*)(dst8 + 8 * kc) = w8;
        } else *(bf16x8*)(dst + 8 * kc) = (bf16x8){lo[0], lo[1], lo[2], lo[3], hh[0], hh[1], hh[2], hh[3]};
    }
    LDS_WAIT(); asm volatile("" ::: "memory");
}
template <bool GAIN = false, bool FP8 = false>
__device__ __forceinline__ void tr_plain64(const float* W, int K, int N, bf16_t* WT, LAS unsigned char* scr, int item, int lane, const float* gain = nullptr) {
    const int nblk = N / 64, kb = item / nblk, nb = item % nblk;
    tr_item64<GAIN, FP8>(W, N, 64 * kb, 64 * nb, WT, K, 64 * nb, scr, lane, gain);
}
template <bool GAIN = false, bool FP8 = false>
__device__ __forceinline__ void tr_gateup64(const float* Wg, const float* Wu, int K, int F, bf16_t* WT, LAS unsigned char* scr, int item, int lane, const float* gain = nullptr) {
    const int nblk = (2 * F) / 64, kb = item / nblk, nb = item % nblk, n0 = 64 * nb, p = n0 >> 8, x = n0 & 255;
    tr_item64<GAIN, FP8>(x < 128 ? Wg : Wu, F, 64 * kb, 128 * p + (x & 127), WT, K, n0, scr, lane, gain);
}

__device__ __forceinline__ void load_gain(const float* g, f32x4 (&gv)[4], int lane) {
#pragma unroll
    for (int j = 0; j < 4; ++j) gv[j] = ((const f32x4*)g)[64 * j + lane];
}
__device__ __forceinline__ void norm_pass(const Frame& F, const float* x, const float* g, bf16_t* hn) {
    f32x4 gv[4]; load_gain(g, gv, F.lane);
    const int gw = F.bid * NWAVES + F.wave, NGW = F.G * NWAVES;
    f32x4 v[4], vn[4];
    if (gw < T) { const f32x4* xr = (const f32x4*)(x + (size_t)gw * DM) + F.lane;
#pragma unroll
        for (int j = 0; j < 4; ++j) v[j] = xr[64 * j]; }
    for (int m = gw; m < T; m += NGW) {
        const int mn = m + NGW < T ? m + NGW : m;
        { const f32x4* xr = (const f32x4*)(x + (size_t)mn * DM) + F.lane;
#pragma unroll
          for (int j = 0; j < 4; ++j) vn[j] = xr[64 * j]; }
        __builtin_amdgcn_sched_barrier(0);
        float s = 0.f;
#pragma unroll
        for (int j = 0; j < 4; ++j) s += (v[j].x * v[j].x + v[j].y * v[j].y) + (v[j].z * v[j].z + v[j].w * v[j].w);
        const float r = __builtin_amdgcn_rsqf(wave_sum(s) * (1.f / DM) + RMS_EPS);
        u32x2* o8 = (u32x2*)(hn + (size_t)m * DM) + F.lane;
#pragma unroll
        for (int j = 0; j < 4; ++j) { const f32x4 y = v[j] * r * gv[j]; u32x2 w; w.x = pk2(y.x, y.y); w.y = pk2(y.z, y.w); o8[64 * j] = w; }
#pragma unroll
        for (int j = 0; j < 4; ++j) v[j] = vn[j];
    }
}

__device__ __forceinline__ float max3f(float a, float b, float c) { float r; asm("v_max3_f32 %0, %1, %2, %3" : "=v"(r) : "v"(a), "v"(b), "v"(c)); return r; }
constexpr int DA_K = 0, DA_V = 49152, DA_POS = 98304, DA_WS = DA_POS + 2048, DA_OST = DA_WS + 2048, DA_END = DA_OST + 32768;
static_assert(DA_END <= MISC_OFF, "dilated attention LDS");
struct DilUnit { int h, g, dil, res, q0; size_t rowb, srow; };
__device__ __forceinline__ DilUnit dil_decode(int u) {
    DilUnit d; d.h = u & 7; int rest = u >> 3; const int blk64 = rest & 63; rest >>= 6; d.g = rest % 3; const int b = rest / 3;
    const int dsh = 2 * d.g; d.dil = 1 << dsh;
    const int bpr = 64 >> dsh;
    d.res = blk64 / bpr; d.q0 = (blk64 % bpr) * 256;
    d.rowb = (size_t)b * SEQ; d.srow = d.rowb + (size_t)d.res * (SEQ >> dsh); return d;
}
__device__ __forceinline__ void dilated_phase(const Frame& F, const bf16_t* qkv, const int* positions, bf16_t* o3, float* lse) {
    const int lane = F.lane, wid = F.wave, r32 = lane & 31, hi = lane >> 5, tid = F.tid;
    LAS unsigned char* lds = F.lds;
    LAS float* posf = (LAS float*)(lds + DA_POS);
    LAS float* wsf = (LAS float*)(lds + DA_WS) + wid * 64;
    LAS bf16_t* stg = (LAS bf16_t*)(lds + DA_OST) + wid * 2048;
    const unsigned ldsb = att::lds_addr(lds);
    constexpr int NUNITS = BATCH * 3 * 64 * 8;
    int u = F.bid;
    if (u >= NUNITS) return;
    DilUnit d = dil_decode(u);
#define DA_SLAB(D_, part_) (qkv + ((size_t)(((D_).g * 3 + (part_)) * 8 + (D_).h) * T + (D_).srow) * 64)
#define DA_DMA_K(D_) do { const bf16_t* kb_ = DA_SLAB(D_, 1) + wid * 8; _Pragma("unroll") for (int j_ = 0; j_ < 6; ++j_) { int kl_ = (D_).q0 - 128 + 64 * j_ + lane; kl_ = kl_ < 0 ? 0 : kl_; \
        att::glds16(kb_ + (size_t)kl_ * 64, (unsigned)__builtin_amdgcn_readfirstlane(ldsb + DA_K + j_ * 8192 + wid * 1024)); } } while (0)
#define DA_DMA_V(D_) do { const bf16_t* vb_ = DA_SLAB(D_, 2) + (wid >> 2) * 32 + (lane & 3) * 8; _Pragma("unroll") for (int j_ = 0; j_ < 6; ++j_) { int vl_ = (D_).q0 - 128 + 64 * j_ + 16 * (wid & 3) + (lane >> 2); vl_ = vl_ < 0 ? 0 : vl_; \
        att::glds16(vb_ + (size_t)vl_ * 64, (unsigned)__builtin_amdgcn_readfirstlane(ldsb + DA_V + j_ * 8192 + wid * 1024)); } } while (0)
#define DA_QLOAD(Q_, PQ_, D_) do { const int ql_ = (D_).q0 + 32 * wid + r32; const bf16_t* qp_ = DA_SLAB(D_, 0) + (size_t)ql_ * 64 + hi * 8; \
        _Pragma("unroll") for (int d0_ = 0; d0_ < 4; ++d0_) Q_[d0_] = *(const bf16x8*)(qp_ + d0_ * 16); PQ_ = positions[(D_).rowb + (size_t)ql_ * (D_).dil + (D_).res]; } while (0)
#define DA_POSLOAD(P_, D_) do { int kl_ = (D_).q0 - 128 + (tid < 384 ? tid : 128); kl_ = kl_ < 0 ? 0 : kl_; P_ = positions[(D_).rowb + (size_t)kl_ * (D_).dil + (D_).res]; } while (0)
    bf16x8 qr[4]; int posqi = 0, posn = 0;
    DA_POSLOAD(posn, d);
    posf[tid] = (float)posn;
    DA_DMA_K(d);
    DA_QLOAD(qr, posqi, d);
#define DA_TOP(N) do { ATT_WAIT_BAR(N); _Pragma("unroll") for (int d0_ = 0; d0_ < 4; ++d0_) asm volatile("" : "+v"(qr[d0_])); asm volatile("" : "+v"(posqi)); } while (0)
    DA_TOP(0);
#pragma unroll 1
    for (;;) {
        DA_DMA_V(d);
        const int un = u + F.G; const bool has_next = un < NUNITS;
        const DilUnit dn = dil_decode(has_next ? un : u);
        if (has_next) DA_POSLOAD(posn, dn);
        __builtin_amdgcn_sched_barrier(0);
        const float posq = (float)posqi;
        const float slope2 = __builtin_amdgcn_exp2f(-(float)(d.h + 1)) * LOG2E;
        const int j0 = wid >> 1;
        f32x16 p0[3], p1[3];
#pragma unroll
        for (int jj = 0; jj < 3; ++jj) {
            const int j = j0 + jj;
            att::qkt<4>(p0[jj], p1[jj], lds + DA_K + j * 8192, qr, r32, hi);
            const int relb = 128 + 32 * wid + r32 - 64 * j, klb = d.q0 - 128 + 64 * j;
            const int lo = max(relb - 128, -klb);
            const unsigned spanp1 = (unsigned)max(relb - lo + 1, 0);
            const int ub = 4 * hi - lo;
            const LAS f32x4* pk4 = (const LAS f32x4*)(posf + 64 * j + 4 * hi);
#pragma unroll
            for (int gq = 0; gq < 4; ++gq) {
                const f32x4 k0v = pk4[2 * gq], k1v = pk4[2 * gq + 8];
#pragma unroll
                for (int c = 0; c < 4; ++c) { const int r = 4 * gq + c;
                    { const bool ok = (unsigned)(ub + 8 * gq + c) < spanp1; const float dd = posq - k0v[c]; const float v = __builtin_fmaf(-slope2, __builtin_fabsf(dd), p0[jj][r]); p0[jj][r] = ok ? v : -INFINITY; }
                    { const bool ok = (unsigned)(ub + 8 * gq + c + 32) < spanp1; const float dd = posq - k1v[c]; const float v = __builtin_fmaf(-slope2, __builtin_fabsf(dd), p1[jj][r]); p1[jj][r] = ok ? v : -INFINITY; } }
            }
        }
        float m;
        { float a = max3f(p0[0][0], p0[0][1], p1[0][0]), bq = max3f(p0[0][2], p0[0][3], p1[0][1]); a = max3f(a, p1[0][2], p1[0][3]);
#pragma unroll
          for (int jj = 0; jj < 3; ++jj)
#pragma unroll
              for (int r = (jj == 0 ? 4 : 0); r < 16; r += 4) { a = max3f(a, p0[jj][r], p0[jj][r + 1]); bq = max3f(bq, p0[jj][r + 2], p0[jj][r + 3]); a = max3f(a, p1[jj][r], p1[jj][r + 1]); bq = max3f(bq, p1[jj][r + 2], p1[jj][r + 3]); }
          float rm = fmaxf(a, bq); { auto rr = __builtin_amdgcn_permlane32_swap(__float_as_uint(rm), __float_as_uint(rm), false, false); rm = fmaxf(__uint_as_float(rr[0]), __uint_as_float(rr[1])); }
          m = rm; }
        float l_run = 0.f;
#pragma unroll
        for (int jj = 0; jj < 3; ++jj) { float s0 = 0.f, s1 = 0.f;
#pragma unroll
            for (int r = 0; r < 16; ++r) { p0[jj][r] = fast_exp2(p0[jj][r] - m); p1[jj][r] = fast_exp2(p1[jj][r] - m); s0 += p0[jj][r]; s1 += p1[jj][r]; }
            l_run += s0 + s1; }
        ATT_WAIT_BAR(0);
        bf16x8 qn[4]; int posqn = 0;
        if (has_next) {
            posf[tid] = (float)posn;
            DA_DMA_K(dn);
            DA_QLOAD(qn, posqn, dn);
        } else {
#pragma unroll
            for (int d0 = 0; d0 < 4; ++d0) qn[d0] = qr[d0];
        }
        __builtin_amdgcn_sched_barrier(0);
        f32x16 o[2];
#pragma unroll
        for (int r = 0; r < 16; ++r) { o[0][r] = 0.f; o[1][r] = 0.f; }
#pragma unroll
        for (int jj = 0; jj < 3; ++jj) att::pv_step(o, p0[jj], p1[jj], lds + DA_V + (j0 + jj) * 8192, lane, hi);
        const float l = att::finish_rows(o, l_run, wsf, stg, r32, hi);
        const size_t qrow = d.rowb + (size_t)(d.q0 + 32 * wid + r32) * d.dil + d.res;
        if (hi == 0) lse[((size_t)d.g * T + qrow) * 8 + d.h] = m + __builtin_amdgcn_logf(l);
        bf16_t* obase = o3 + (size_t)d.g * T * DSAW + d.h * 64;
#pragma unroll
        for (int i = 0; i < 4; ++i) { const int row = i * 8 + (lane >> 3), ch = lane & 7; const u32x4 v = *(const LAS u32x4*)(stg + row * 64 + ch * 8);
            const size_t orow = d.rowb + (size_t)(d.q0 + 32 * wid + row) * d.dil + d.res;
            *(u32x4*)(obase + orow * DSAW + ch * 8) = v; }
        if (!has_next) break;
        u = un; d = dn; posqi = posqn;
#pragma unroll
        for (int d0 = 0; d0 < 4; ++d0) qr[d0] = qn[d0];
        DA_TOP(4);
    }
    ATT_WAIT_BAR(0);
#undef DA_TOP
#undef DA_SLAB
#undef DA_DMA_K
#undef DA_DMA_V
#undef DA_QLOAD
#undef DA_POSLOAD
}
__device__ __forceinline__ void merge_pass(const Frame& F, const bf16_t* o3, const float* lse, bf16_t* mix) {
    const int gw = F.bid * NWAVES + F.wave, NGW = F.G * NWAVES, lane = F.lane, h = lane >> 3;
    float l[3], ln[3]; u32x4 a[3], an[3];
#define MG_LOAD(L_, A_, m_) do { _Pragma("unroll") for (int g_ = 0; g_ < 3; ++g_) { L_[g_] = lse[((size_t)g_ * T + (m_)) * 8 + h]; A_[g_] = *(const u32x4*)(o3 + ((size_t)g_ * T + (m_)) * DSAW + lane * 8); } } while (0)
    if (gw < T) MG_LOAD(l, a, gw);
    for (int m = gw; m < T; m += NGW) {
        const int mn = m + NGW < T ? m + NGW : m;
        MG_LOAD(ln, an, mn);
        __builtin_amdgcn_sched_barrier(0);
        const float mx = fmaxf(l[0], fmaxf(l[1], l[2]));
        float l0 = fast_exp2(l[0] - mx), l1 = fast_exp2(l[1] - mx), l2 = fast_exp2(l[2] - mx);
        const float inv = fast_rcp(l0 + l1 + l2); l0 *= inv; l1 *= inv; l2 *= inv;
        u32x4 w;
#pragma unroll
        for (int k = 0; k < 4; ++k) w[k] = pk2(l0 * bflo(a[0][k]) + l1 * bflo(a[1][k]) + l2 * bflo(a[2][k]), l0 * bfhi(a[0][k]) + l1 * bfhi(a[1][k]) + l2 * bfhi(a[2][k]));
        *(u32x4*)(mix + (size_t)m * DSAW + lane * 8) = w;
#pragma unroll
        for (int g = 0; g < 3; ++g) { l[g] = ln[g]; a[g] = an[g]; }
    }
#undef MG_LOAD
}

__device__ __forceinline__ void mla_pv(f32x16 (&o)[2], const u32x4 (&pw)[4], const LAS unsigned char* Vslot, int lane, int hi) {
    const LAS unsigned char* vb = Vslot + ((lane >> 4) & 1) * 32 + (lane & 3) * 8 + (4 * hi + ((lane & 15) >> 2)) * 64;
#pragma unroll
    for (int ks = 0; ks < 4; ++ks)
#pragma unroll
        for (int d0 = 0; d0 < 2; ++d0) {
            const s16x4 lo = __builtin_bit_cast(s16x4, __builtin_amdgcn_ds_read_tr16_b64_v4i16((LAS att::v4i16_t*)(vb + d0 * 4096 + ks * 1024)));
            const s16x4 hh = __builtin_bit_cast(s16x4, __builtin_amdgcn_ds_read_tr16_b64_v4i16((LAS att::v4i16_t*)(vb + d0 * 4096 + ks * 1024 + 512)));
            const bf16x8 vf = (bf16x8){lo[0], lo[1], lo[2], lo[3], hh[0], hh[1], hh[2], hh[3]};
            o[d0] = __builtin_amdgcn_mfma_f32_32x32x16_bf16(__builtin_bit_cast(bf16x8, pw[ks]), vf, o[d0], 0, 0, 0);
        }
}
constexpr int H4_K = 0, H4_KS = 12288, H4_V = 4 * H4_KS, H4_VS = 8192, H4_WS = H4_V + 3 * H4_VS, H4_OST = H4_WS + 2048, H4_END = H4_OST + 32768;
static_assert(H4_END <= MISC_OFF, "mla attention (hand-interleaved) LDS");
__device__ __forceinline__ void mla_attn_phase4(const Frame& F, const bf16_t* Q, const bf16_t* KV, const bf16_t* KR, bf16_t* O) {
    const int lane = F.lane, wid = F.wave, r32 = lane & 31, hi = lane >> 5;
    LAS unsigned char* lds = F.lds;
    LAS float* wsf = (LAS float*)(lds + H4_WS) + wid * 64;
    LAS bf16_t* stg = (LAS bf16_t*)(lds + H4_OST) + wid * 2048;
    const unsigned ldsb = att::lds_addr(lds);
    volatile LAS unsigned* redo_flag = (volatile LAS unsigned*)(lds + MISC_OFF) + 24;
    const int vcu = (F.G % 8 == 0) ? (F.bid % 8) * (F.G / 8) + F.bid / 8 : F.bid;
    constexpr int NQB = SEQ / 256;
    constexpr int NUNITS = BATCH * NH * NQB;
    const int nper = (NUNITS + F.G - 1) / F.G;
    const LAS unsigned char* kp0 = lds + H4_K + hi * 1024 + r32 * 16;
    const LAS unsigned char* vp0 = lds + H4_V + ((lane >> 4) & 1) * 32 + (lane & 3) * 8 + (4 * hi + ((lane & 15) >> 2)) * 64;
#define H4_SB() __builtin_amdgcn_sched_barrier(0)
#define H4_PIN(x) asm volatile("" : "+v"(x))
#define H4_WAIT_BAR(N) asm volatile("s_waitcnt vmcnt(" #N ") lgkmcnt(0)\n\ts_barrier" ::: "memory")
#define H4_WAIT3() do { if (wid < 4) { H4_WAIT_BAR(3); } else { H4_WAIT_BAR(2); } } while (0)
#define H4_VTR(p) __builtin_bit_cast(s16x4, __builtin_amdgcn_ds_read_tr16_b64_v4i16((LAS att::v4i16_t*)(p)))
#define H4_MFMA(a, b, c) __builtin_amdgcn_mfma_f32_32x32x16_bf16(a, b, c, 0, 0, 0)
#define H4_Z (f32x16){0.f, 0.f, 0.f, 0.f, 0.f, 0.f, 0.f, 0.f, 0.f, 0.f, 0.f, 0.f, 0.f, 0.f, 0.f, 0.f}
    for (int i = 0; i < nper; ++i) {
        int bh, qb;
        if (F.G == 256) { const int s = vcu & 7; bh = vcu >> 3; const int k2 = i >> 1; qb = (i & 1) ? (16 * k2 + 15 - s) : (16 * k2 + s); }
        else { const int it = i * F.G + F.bid; if (it >= NUNITS) break; bh = it / NQB; qb = NQB - 1 - (it % NQB); }
        bool safe = false;
        for (;;) {
        const int b = bh / NH, h = bh % NH;
        const size_t rowb = (size_t)b * SEQ; const int q0 = qb * 256;
        const int NT = 4 * (qb + 1);
        int ln_ = threadIdx.x & 63; asm volatile("" : "+v"(ln_));
        const bf16_t* ksrc = KV + (rowb + ln_) * KVC + h * 128 + wid * 8;
        const bf16_t* rsrc = KR + (rowb + ln_) * 32 + (wid & 3) * 8;
        const bf16_t* vsrc = KV + (rowb + 16 * (wid & 3) + (ln_ >> 2)) * KVC + h * 128 + 64 + (wid >> 2) * 32 + (ln_ & 3) * 8;
#define H4_DMA_K(t, slot) do { \
        att::glds16(ksrc + (size_t)(t) * 64 * KVC, (unsigned)__builtin_amdgcn_readfirstlane(ldsb + H4_K + (slot) * H4_KS + wid * 1024)); \
        if (wid < 4) att::glds16(rsrc + (size_t)(t) * 64 * 32, (unsigned)__builtin_amdgcn_readfirstlane(ldsb + H4_K + (slot) * H4_KS + (8 + wid) * 1024)); } while (0)
#define H4_DMA_V(t, slot) att::glds16(vsrc + (size_t)(t) * 64 * KVC, (unsigned)__builtin_amdgcn_readfirstlane(ldsb + H4_V + (slot) * H4_VS + wid * 1024))
        H4_DMA_K(0, 0); H4_DMA_V(0, 0); H4_DMA_K(1, 1);
        bf16x8 qr[6];
        { const bf16_t* qp = Q + (rowb + q0 + 32 * wid + (ln_ & 31)) * QC + h * HQ + (ln_ >> 5) * 8;
#pragma unroll
          for (int d0 = 0; d0 < 6; ++d0) qr[d0] = *(const bf16x8*)(qp + d0 * 16); }
        float mhat = 0.f, l_reg = 0.f; f32x16 o[2], pA0, pA1, pB0, pB1, negm; bool resc = false;
#pragma unroll
        for (int r = 0; r < 16; ++r) { o[0][r] = 0.f; o[1][r] = 0.f; negm[r] = 0.f; }
        H4_PIN(negm);
        const int qrel = 32 * wid + r32;
        int sp = 0, sc = 0, sn = 1, kc = 0;
#define H4_ROT() do { sp = sc; sc = sn; sn = (sn == 2) ? 0 : sn + 1; kc = (kc + 1) & 3; } while (0)
#define H4_CMASK(P0, P1, t) do { const int jb_ = (t) - (NT - 4); if (jb_ >= 0) { _Pragma("unroll") for (int r = 0; r < 16; ++r) { const int kv_ = 64 * jb_ + att::crow(r, hi); if (kv_ > qrel) P0[r] = -INFINITY; if (kv_ + 32 > qrel) P1[r] = -INFINITY; } } } while (0)
#define H4_RESC() do { if (resc) { LDS_WAIT(); _Pragma("unroll") for (int d_ = 0; d_ < 2; ++d_) _Pragma("unroll") for (int r = 0; r < 16; ++r) o[d_][r] *= wsf[att::crow(r, hi)]; } } while (0)
        H4_DMA_K(2, 2);
#pragma unroll
        for (int d0 = 0; d0 < 6; ++d0) H4_PIN(qr[d0]);
        if (wid < 4) { H4_WAIT_BAR(5); } else { H4_WAIT_BAR(3); }
        { const LAS unsigned char* kb = kp0;
#pragma unroll
          for (int d0 = 0; d0 < 6; ++d0) { const bf16x8 b0 = *(const LAS bf16x8*)(kb + d0 * 2048), b1 = *(const LAS bf16x8*)(kb + d0 * 2048 + 512);
              if (d0 == 0) { pA0 = H4_MFMA(b0, qr[0], H4_Z); pA1 = H4_MFMA(b1, qr[0], H4_Z); } else { pA0 = H4_MFMA(b0, qr[d0], pA0); pA1 = H4_MFMA(b1, qr[d0], pA1); } } }
        H4_CMASK(pA0, pA1, 0);
        asm volatile("s_nop 15\n\ts_nop 7" : "+v"(pA0), "+v"(pA1));
        { float a = max3f(pA0[0], pA0[1], pA1[0]), bq = max3f(pA0[2], pA0[3], pA1[1]); a = max3f(a, pA1[2], pA1[3]);
#pragma unroll
          for (int r = 4; r < 16; r += 4) { a = max3f(a, pA0[r], pA0[r + 1]); bq = max3f(bq, pA0[r + 2], pA0[r + 3]); a = max3f(a, pA1[r], pA1[r + 1]); bq = max3f(bq, pA1[r + 2], pA1[r + 3]); }
          float rm = fmaxf(a, bq); { auto rr = __builtin_amdgcn_permlane32_swap(__float_as_uint(rm), __float_as_uint(rm), false, false); rm = fmaxf(__uint_as_float(rr[0]), __uint_as_float(rr[1])); }
          mhat = rm;
#pragma unroll
          for (int r = 0; r < 16; ++r) { pA0[r] = fast_exp2(pA0[r] - rm); pA1[r] = fast_exp2(pA1[r] - rm); negm[r] = -rm; }
          H4_PIN(negm); }
        H4_WAIT_BAR(0);
        if (F.tid == 0) *redo_flag = 0u;
        H4_DMA_K(3, 3); H4_DMA_V(1, 1);
        H4_ROT();
        bf16x8 kf[12];
#pragma unroll
        for (int j = 0; j < 4; ++j) { kf[2 * j] = *(const LAS bf16x8*)(kp0 + kc * H4_KS + j * 2048); kf[2 * j + 1] = *(const LAS bf16x8*)(kp0 + kc * H4_KS + j * 2048 + 512); }
        H4_WAIT3();
        s16x4 vlo[4], vhi[4]; u32x4 pw0, pw1, pw2, pw3;
#define H4_PKW(P, B) pk2(P[B], P[B + 1])
#define H4_PAF(k) __builtin_bit_cast(bf16x8, pw##k)
#define H4_VFR(s_) (bf16x8){vlo[s_][0], vlo[s_][1], vlo[s_][2], vlo[s_][3], vhi[s_][0], vhi[s_][1], vhi[s_][2], vhi[s_][3]}
#define H4_MX3(a, b, c) __builtin_fmaxf(__builtin_fmaxf((a), (b)), (c))
#define H4_GAPA(MF, A0, A1, A2, A3, W0, W1, PW) do { MF; sacc += A0; sacc += A1; sacc += A2; sacc += A3; H4_PIN(sacc); W0; W1; H4_PIN(PW); H4_SB(); } while (0)
#define H4_GAPM(MF) do { MF; H4_SB(); } while (0)
#define H4_GAPB(MF, X, B) do { MF; X[B] = fast_exp2(X[B]); X[B + 1] = fast_exp2(X[B + 1]); X[B + 2] = fast_exp2(X[B + 2]); X[B + 3] = fast_exp2(X[B + 3]); H4_PIN(X); H4_SB(); } while (0)
#define H4_VRD(s_, i) do { vlo[s_] = H4_VTR(vp_ + (((i) >> 2) * 4096 + ((i) & 3) * 1024)); vhi[s_] = H4_VTR(vp_ + (((i) >> 2) * 4096 + ((i) & 3) * 1024 + 512)); } while (0)
#define H4_KRD(G, j) do { if (G) { kf[2 * (j)] = *(const LAS bf16x8*)(kn_ + (j) * 2048); kf[2 * (j) + 1] = *(const LAS bf16x8*)(kn_ + (j) * 2048 + 512); H4_SB(); } } while (0)
#define H4_KRR(j) do { kf[2 * (j)] = *(const LAS bf16x8*)(kc_ + (j) * 2048); kf[2 * (j) + 1] = *(const LAS bf16x8*)(kc_ + (j) * 2048 + 512); } while (0)
#define H4_STEP(C0, C1, P0, P1, t, GK, GV, GL, BAND) do { H4_SB(); \
        const LAS unsigned char* vp_ = vp0 + sp * H4_VS; const LAS unsigned char* kn_ = kp0 + ((kc + 1) & 3) * H4_KS; const LAS unsigned char* kc_ = kp0 + kc * H4_KS; \
        float sacc = (P0[0] + P0[1]); \
        H4_GAPA(C0 = H4_MFMA(kf[0], qr[0], negm), P0[2], P0[3], P0[4], P0[5],     pw0[0] = H4_PKW(P0, 0), pw0[1] = H4_PKW(P0, 2), pw0); \
        H4_GAPA(C1 = H4_MFMA(kf[1], qr[0], negm), P0[6], P0[7], P0[8], P0[9],     pw0[2] = H4_PKW(P0, 4), pw0[3] = H4_PKW(P0, 6), pw0); \
        H4_GAPA(C0 = H4_MFMA(kf[2], qr[1], C0),   P0[10], P0[11], P0[12], P0[13], pw1[0] = H4_PKW(P0, 8), pw1[1] = H4_PKW(P0, 10), pw1); \
        H4_GAPA(C1 = H4_MFMA(kf[3], qr[1], C1),   P0[14], P0[15], P1[0], P1[1],   pw1[2] = H4_PKW(P0, 12), pw1[3] = H4_PKW(P0, 14), pw1); \
        H4_KRR(4); H4_SB(); H4_GAPA(C0 = H4_MFMA(kf[4], qr[2], C0),   P1[2], P1[3], P1[4], P1[5],     pw2[0] = H4_PKW(P1, 0), pw2[1] = H4_PKW(P1, 2), pw2); \
        H4_KRR(5); H4_SB(); H4_GAPA(C1 = H4_MFMA(kf[5], qr[2], C1),   P1[6], P1[7], P1[8], P1[9],     pw2[2] = H4_PKW(P1, 4), pw2[3] = H4_PKW(P1, 6), pw2); \
        H4_VRD(0, 0); H4_SB(); H4_GAPA(C0 = H4_MFMA(kf[6], qr[3], C0),   P1[10], P1[11], P1[12], P1[13], pw3[0] = H4_PKW(P1, 8), pw3[1] = H4_PKW(P1, 10), pw3); \
        H4_VRD(1, 4); H4_SB(); H4_GAPA(C1 = H4_MFMA(kf[7], qr[3], C1),   P1[14], P1[15], 0.f, 0.f,       pw3[2] = H4_PKW(P1, 12), pw3[3] = H4_PKW(P1, 14), pw3); \
        H4_VRD(2, 1); H4_KRD(GL, 0); H4_SB(); H4_GAPM(C0 = H4_MFMA(kf[8], qr[4], C0)); H4_VRD(3, 5); H4_KRD(GL, 1); H4_SB(); H4_GAPM(C1 = H4_MFMA(kf[9], qr[4], C1)); if (GK) { H4_DMA_K((t) + 3, (kc + 3) & 3); H4_SB(); } \
        H4_KRD(GL, 2); H4_GAPM(C0 = H4_MFMA(kf[10], qr[5], C0)); if (GV) { H4_DMA_V((t) + 1, sn); H4_SB(); } \
        H4_KRD(GL, 3); H4_GAPM(C1 = H4_MFMA(kf[11], qr[5], C1)); \
        l_reg += sacc; \
        if (BAND) H4_CMASK(C0, C1, t); \
        resc = false; \
        if (safe) { float a = H4_MX3(C0[0], C0[1], C1[0]), bq = H4_MX3(C0[2], C0[3], C1[1]); a = H4_MX3(a, C1[2], C1[3]); \
          _Pragma("unroll") for (int r = 4; r < 16; r += 4) { a = H4_MX3(a, C0[r], C0[r + 1]); bq = H4_MX3(bq, C0[r + 2], C0[r + 3]); a = H4_MX3(a, C1[r], C1[r + 1]); bq = H4_MX3(bq, C1[r + 2], C1[r + 3]); } \
          float rm = __builtin_fmaxf(a, bq); { auto rr = __builtin_amdgcn_permlane32_swap(__float_as_uint(rm), __float_as_uint(rm), false, false); rm = __builtin_fmaxf(__uint_as_float(rr[0]), __uint_as_float(rr[1])); } \
          if (__builtin_expect(__any(rm > 8.f), 0)) { const float dl = __builtin_fmaxf(rm, 0.f); mhat += dl; \
              _Pragma("unroll") for (int r = 0; r < 16; ++r) { C0[r] -= dl; C1[r] -= dl; } \
              _Pragma("unroll") for (int r = 0; r < 16; ++r) negm[r] = -mhat; H4_PIN(negm); \
              const float f = fast_exp2(-dl); l_reg *= f; if (hi == 0) { int ri_ = threadIdx.x & 31; asm volatile("" : "+v"(ri_)); wsf[ri_] = f; } resc = true; } } \
        H4_SB(); \
        H4_GAPB(o[0] = H4_MFMA(H4_PAF(0), H4_VFR(0), o[0]), C0, 0); \
        H4_VRD(0, 2); H4_SB(); H4_GAPB(o[1] = H4_MFMA(H4_PAF(0), H4_VFR(1), o[1]), C0, 4); \
        H4_VRD(1, 6); H4_SB(); H4_GAPB(o[0] = H4_MFMA(H4_PAF(1), H4_VFR(2), o[0]), C0, 8); \
        H4_VRD(2, 3); H4_SB(); H4_GAPB(o[1] = H4_MFMA(H4_PAF(1), H4_VFR(3), o[1]), C0, 12); \
        H4_VRD(3, 7); H4_SB(); H4_GAPB(o[0] = H4_MFMA(H4_PAF(2), H4_VFR(0), o[0]), C1, 0); \
        H4_GAPB(o[1] = H4_MFMA(H4_PAF(2), H4_VFR(1), o[1]), C1, 4); \
        H4_GAPB(o[0] = H4_MFMA(H4_PAF(3), H4_VFR(2), o[0]), C1, 8); \
        H4_GAPB(o[1] = H4_MFMA(H4_PAF(3), H4_VFR(3), o[1]), C1, 12); \
        } while (0)
        int t = 1;
        for (; t + 5 < NT; t += 2) {
            H4_STEP(pB0, pB1, pA0, pA1, t, true, true, true, false);     H4_WAIT3(); H4_RESC(); H4_ROT();
            H4_STEP(pA0, pA1, pB0, pB1, t + 1, true, true, true, false); H4_WAIT3(); H4_RESC(); H4_ROT();
        }
#define H4_ENDW(tt) do { if ((tt) + 3 < NT) { H4_WAIT3(); } else if ((tt) + 2 < NT) { H4_WAIT_BAR(1); } else { H4_WAIT_BAR(0); } } while (0)
        for (; t + 1 < NT; t += 2) {
            H4_STEP(pB0, pB1, pA0, pA1, t, (t + 3 < NT), (t + 1 < NT), (t + 1 < NT), true);         H4_ENDW(t);     H4_RESC(); H4_ROT();
            H4_STEP(pA0, pA1, pB0, pB1, t + 1, (t + 4 < NT), (t + 2 < NT), (t + 2 < NT), true);     H4_ENDW(t + 1); H4_RESC(); H4_ROT();
        }
        H4_STEP(pB0, pB1, pA0, pA1, NT - 1, false, false, false, true); H4_RESC();
        { float sacc = pB0[0] + pB0[1];
#pragma unroll
          for (int r = 2; r < 16; ++r) sacc += pB0[r];
#pragma unroll
          for (int r = 0; r < 16; ++r) sacc += pB1[r];
          l_reg += sacc;
          u32x4 pw[4];
          pw[0] = (u32x4){H4_PKW(pB0, 0), H4_PKW(pB0, 2), H4_PKW(pB0, 4), H4_PKW(pB0, 6)}; pw[1] = (u32x4){H4_PKW(pB0, 8), H4_PKW(pB0, 10), H4_PKW(pB0, 12), H4_PKW(pB0, 14)};
          pw[2] = (u32x4){H4_PKW(pB1, 0), H4_PKW(pB1, 2), H4_PKW(pB1, 4), H4_PKW(pB1, 6)}; pw[3] = (u32x4){H4_PKW(pB1, 8), H4_PKW(pB1, 10), H4_PKW(pB1, 12), H4_PKW(pB1, 14)};
          H4_SB(); mla_pv(o, pw, lds + H4_V + sc * H4_VS, lane, hi); }
#undef H4_DMA_K
#undef H4_DMA_V
#undef H4_ROT
#undef H4_CMASK
#undef H4_RESC
#undef H4_PKW
#undef H4_PAF
#undef H4_VFR
#undef H4_MX3
#undef H4_GAPA
#undef H4_GAPM
#undef H4_GAPB
#undef H4_VRD
#undef H4_KRD
#undef H4_KRR
#undef H4_STEP
#undef H4_ENDW
        int le_ = threadIdx.x & 63; asm volatile("" : "+v"(le_));
        if (__any(!(l_reg < 1e18f)) && le_ == 0) *redo_flag = 1u;
        (void)att::finish_rows(o, l_reg, wsf, stg, le_ & 31, le_ >> 5);
        bf16_t* ob = O + (rowb + q0 + 32 * wid) * DM + h * 64;
#pragma unroll
        for (int i2 = 0; i2 < 4; ++i2) { const int row = i2 * 8 + (le_ >> 3), ch = le_ & 7; const u32x4 v = *(const LAS u32x4*)(stg + row * 64 + ch * 8); *(u32x4*)(ob + (size_t)row * DM + ch * 8) = v; }
        ATT_WAIT_BAR(0);
        const unsigned redo = __builtin_amdgcn_readfirstlane(*redo_flag);
        if (safe || redo == 0u) break;
        safe = true;
        }
    }
#undef H4_SB
#undef H4_PIN
#undef H4_WAIT_BAR
#undef H4_WAIT3
#undef H4_VTR
#undef H4_MFMA
#undef H4_Z
}

__device__ __forceinline__ void router_pass(const Frame& F, const bf16_t* xb, const float* g, const float* wrouter, float* r3, int* e01, float* gwt, int* cnt, int* list, float* rsrow, unsigned* x8) {
    LAS float* wr = (LAS float*)F.lds;
    LAS int* lc = (LAS int*)(F.lds + 32768);
    for (int i = F.tid; i < DM * NEXP / 4; i += NWAVES * 64) ((LAS f32x4*)wr)[i] = ((const f32x4*)wrouter)[i];
    for (int i = F.bid * NWAVES * 64 + F.tid; i < 2 * MOE_MAXROWS; i += F.G * NWAVES * 64) { list[i] = -1; rsrow[i] = 1.f; }
    f32x4 gv[4]; load_gain(g, gv, F.lane);
    const int lane = F.lane;
    for (int ch = F.bid; ch < T / 128; ch += F.G) {
        if (F.tid < 16) lc[F.tid] = 0;
        __syncthreads();
        f32x4 v[4]; u32x2 vn[4];
        { const u32x2* xr = (const u32x2*)(xb + (size_t)(ch * 128 + F.wave * 16) * DM) + lane;
#pragma unroll
          for (int j = 0; j < 4; ++j) vn[j] = xr[64 * j]; }
        for (int rr = 0; rr < 16; ++rr) {
            const int m = ch * 128 + F.wave * 16 + rr;
#pragma unroll
            for (int j = 0; j < 4; ++j) v[j] = (f32x4){bflo(vn[j].x), bfhi(vn[j].x), bflo(vn[j].y), bfhi(vn[j].y)};
            { const int mn = rr < 15 ? m + 1 : m; const u32x2* xr = (const u32x2*)(xb + (size_t)mn * DM) + lane;
#pragma unroll
              for (int j = 0; j < 4; ++j) vn[j] = xr[64 * j]; }
            __builtin_amdgcn_sched_barrier(0);
            { float s = 0.f;
#pragma unroll
              for (int j = 0; j < 4; ++j) s += (v[j].x * v[j].x + v[j].y * v[j].y) + (v[j].z * v[j].z + v[j].w * v[j].w);
              const float r = __builtin_amdgcn_rsqf(wave_sum(s) * (1.f / DM) + RMS_EPS);
              if (lane == 0) r3[m] = r;
#pragma unroll
              for (int j = 0; j < 4; ++j) x8[(size_t)m * (DM / 4) + 64 * j + lane] = pk4_fp8(__builtin_amdgcn_fmed3f(v[j].x * 2.f, -448.f, 448.f), __builtin_amdgcn_fmed3f(v[j].y * 2.f, -448.f, 448.f), __builtin_amdgcn_fmed3f(v[j].z * 2.f, -448.f, 448.f), __builtin_amdgcn_fmed3f(v[j].w * 2.f, -448.f, 448.f));
#pragma unroll
              for (int j = 0; j < 4; ++j) v[j] = v[j] * r * gv[j]; }
            float lg[NEXP];
#pragma unroll
            for (int e = 0; e < NEXP; ++e) lg[e] = 0.f;
#pragma unroll
            for (int j = 0; j < 4; ++j)
#pragma unroll
                for (int k = 0; k < 4; ++k) { const int col = 4 * (64 * j + lane) + k; const f32x4 w0 = *(const LAS f32x4*)(wr + col * 8), w1 = *(const LAS f32x4*)(wr + col * 8 + 4); const float xv = v[j][k];
                    lg[0] += xv * w0.x; lg[1] += xv * w0.y; lg[2] += xv * w0.z; lg[3] += xv * w0.w; lg[4] += xv * w1.x; lg[5] += xv * w1.y; lg[6] += xv * w1.z; lg[7] += xv * w1.w; }
#pragma unroll
            for (int e = 0; e < NEXP; ++e) lg[e] = wave_sum(lg[e]);
            int i0 = 0; float b0 = lg[0];
#pragma unroll
            for (int e = 1; e < NEXP; ++e) if (lg[e] > b0) { b0 = lg[e]; i0 = e; }
            int i1 = -1; float b1 = -INFINITY;
#pragma unroll
            for (int e = 0; e < NEXP; ++e) if (e != i0 && lg[e] > b1) { b1 = lg[e]; i1 = e; }
            const float w1 = 1.f / (1.f + expf(b0 - b1)), w0 = 1.f - w1;
            if (lane == 0) { e01[m] = i0 | (i1 << 8); gwt[2 * m] = w0; gwt[2 * m + 1] = w1; lds_add(&lc[i0], 1); lds_add(&lc[8 + i1], 1); }
        }
        __syncthreads();
        if (F.tid < 16) cnt[ch * 16 + F.tid] = lc[F.tid];
        __syncthreads();
    }
}
__device__ __forceinline__ void list_pass(const Frame& F, const int* e01, const float* gwt, const int* cnt, int* list, float* gws, int* bases, const float* r3, float* rsrow, int* tflag, int tailrow0) {
    LAS int* tot = (LAS int*)F.lds;
    LAS int* pre = tot + 16;
    LAS int* lc = tot + 32;
    LAS int* bs = tot + 48;
    constexpr int NCH = T / 128;
    for (int ch = F.bid; ch < NCH; ch += F.G) {
        if (F.tid < 64) tot[F.tid] = 0;
        __syncthreads();
        for (int i = F.tid; i < NCH * 16; i += NWAVES * 64) { const int c = cnt[i]; lds_add(&tot[i & 15], c); if ((i >> 4) < ch) lds_add(&pre[i & 15], c); }
        __syncthreads();
        if (F.tid < 2) { int acc = 0; for (int e = 0; e < NEXP; ++e) { bs[F.tid * 9 + e] = acc; acc += (tot[F.tid * 8 + e] + 255) & ~255; } bs[F.tid * 9 + 8] = acc; }
        __syncthreads();
        if (ch == 0 && F.tid < 18) bases[F.tid] = bs[F.tid];
        if (F.tid < 128) {
            const int m = ch * 128 + F.tid; const int ee = e01[m]; const int i0 = ee & 255, i1 = ee >> 8;
            const int p0 = lds_add(&lc[i0], 1), p1 = lds_add(&lc[8 + i1], 1);
            const int s0 = bs[i0] + pre[i0] + p0, s1 = bs[9 + i1] + pre[8 + i1] + p1;
            list[s0] = m; gws[s0] = gwt[2 * m] * (1.f / 512.f); list[MOE_MAXROWS + s1] = m; gws[MOE_MAXROWS + s1] = gwt[2 * m + 1] * (1.f / 512.f);
            tflag[m] = (s0 >= tailrow0 || s1 >= tailrow0) ? 1 : 0;
            const float rt = r3[m] * (1.f / 128.f); rsrow[s0] = rt; rsrow[MOE_MAXROWS + s1] = rt;
        }
        __syncthreads();
    }
}

#ifndef PHASE_MASK
#define PHASE_MASK 0xFFFFFFFFu
#endif
#define PH(n) (((PHASE_MASK) >> (n)) & 1u)
__global__ void __launch_bounds__(NWAVES * 64, 2) trunk_fwd(Args args) {
    extern __shared__ __attribute__((aligned(16))) unsigned char lds_raw[];
    Frame F;
    F.lds = (LAS unsigned char*)lds_raw;
    volatile LAS unsigned* MISC = (volatile LAS unsigned*)(F.lds + MISC_OFF);
    F.tid = threadIdx.x; F.lane = F.tid & 63; F.wave = __builtin_amdgcn_readfirstlane(F.tid >> 6);
    F.G = gridDim.x; F.bid = blockIdx.x;
    unsigned char* ws = args.ws;
    for (int u = F.tid; u < (LDS_BYTES - MISC_OFF) / 4; u += NWAVES * 64) ((LAS unsigned*)(F.lds + MISC_OFF))[u] = 0u;
    __syncthreads();
    XcdBarrier bar = xcd_barrier_post((unsigned*)(ws + WS_CTL) + CW_BAR, MISC + 8);
#define GRID_BAR() xcd_barrier(bar)

    const float* x = (const float*)args.in[0]; const int* positions = (const int*)args.in[1];
    const float* mix_g = (const float*)args.in[2]; const float* ffn_g = (const float*)args.in[3];
    float* out = args.out;
    bf16_t* Wqkv = (bf16_t*)(ws + WS_WQKV); bf16_t* Woa = (bf16_t*)(ws + WS_WOA); bf16_t* Wgu0 = (bf16_t*)(ws + WS_WGU0); bf16_t* Wd0 = (bf16_t*)(ws + WS_WD0);
    bf16_t* Win = (bf16_t*)(ws + WS_WIN); bf16_t* Wqup = (bf16_t*)(ws + WS_WQUP); bf16_t* Wkvup = (bf16_t*)(ws + WS_WKVUP); bf16_t* Wob = (bf16_t*)(ws + WS_WOB);
    bf16_t* Wmgu = (bf16_t*)(ws + WS_MOEGU); bf16_t* Wmd = (bf16_t*)(ws + WS_MOED);
    bf16_t* HN = (bf16_t*)(ws + WS_HN); bf16_t* QKV = (bf16_t*)(ws + WS_QKV); bf16_t* O3 = (bf16_t*)(ws + WS_O3); bf16_t* MIX = (bf16_t*)(ws + WS_MIX); bf16_t* ACT0 = (bf16_t*)(ws + WS_ACT0);
    bf16_t* CQ = (bf16_t*)(ws + WS_CQ); bf16_t* CKV = (bf16_t*)(ws + WS_CKV); bf16_t* KR = (bf16_t*)(ws + WS_KR);
    bf16_t* Qb = (bf16_t*)(ws + WS_Q); bf16_t* KVb = (bf16_t*)(ws + WS_KV); bf16_t* Ob = (bf16_t*)(ws + WS_O); bf16_t* ACTE = (bf16_t*)(ws + WS_ACTE);
    float* SSL = (float*)(ws + WS_SSL); float* SSQ = (float*)(ws + WS_SSQ); bf16_t* XB2 = (bf16_t*)(ws + WS_MOEGU); bf16_t* HN8 = (bf16_t*)(ws + WS_HN8); float* RS = (float*)(ws + WS_RS); float* RSROW = (float*)(ws + WS_RSROW); int* TFLAG = (int*)(ws + WS_TFLAG); bf16_t* XB1 = (bf16_t*)(ws + WS_XB1);
    float* COS = (float*)(ws + WS_COS); float* SIN = (float*)(ws + WS_SIN); float* LSE = (float*)(ws + WS_LSE);
    int* E01 = (int*)(ws + WS_E01); float* GWT = (float*)(ws + WS_GWT); int* LIST = (int*)(ws + WS_LIST); float* GWS = (float*)(ws + WS_GWS); int* CNT = (int*)(ws + WS_CNT); int* BASES = (int*)(ws + WS_BASES);
    const int gw = F.bid * NWAVES + F.wave, NGW = F.G * NWAVES;
    LAS float* scr = (LAS float*)(F.lds + F.wave * 16384);
    LAS unsigned char* scr8 = F.lds + F.wave * 16384;

    if (PH(0)) { const Frame FL = phase_frame(F);
        constexpr int I_QKV = 16 * 72, I_OA = 8 * 16, I_GU0 = 16 * 88, I_D0 = 44 * 16, I_IN = 16 * 24, I_QUP = 6 * 48, I_KVUP = 4 * 32, I_OB = 16 * 16;
        constexpr int NITEMS = I_QKV + I_OA + I_GU0 + I_D0 + I_IN + I_QUP + I_KVUP + I_OB;
        for (int it = gw; it < NITEMS; it += NGW) {
            int r = it;
            if (r < I_QKV) { tr_plain64((const float*)args.in[4], DM, QKVC, Wqkv, scr8, r, FL.lane); continue; } r -= I_QKV;
            if (r < I_OA) { tr_plain64((const float*)args.in[5], DSAW, DM, Woa, scr8, r, FL.lane); continue; } r -= I_OA;
            if (r < I_GU0) { tr_gateup64<true>((const float*)args.in[12], (const float*)args.in[13], DM, FF0, Wgu0, scr8, r, FL.lane, ffn_g); continue; } r -= I_GU0;
            if (r < I_D0) { tr_plain64((const float*)args.in[14], FF0, DM, Wd0, scr8, r, FL.lane); continue; } r -= I_D0;
            if (r < I_IN) { const int nblk = MLA_INP / 32, kb = r / nblk, nb = r % nblk; const int p_ = FL.lane & 31;
                tr_item((const float*)args.in[6], MLA_IN, 64 * kb, 32 * nb < QL + KVL ? 32 * nb + p_ : (32 * nb == QL + KVL ? QL + KVL + (p_ & 1) * 16 + (p_ >> 1) : -1), Win, DM, 32 * nb, scr, FL.lane, mix_g + DM); continue; } r -= I_IN;
            if (r < I_QUP) { const int nblk = QC / 32, kb = r / nblk, nb = r % nblk, n0 = 32 * nb, hh = n0 / HQ, cc = n0 % HQ; const int p = FL.lane & 31;
                const int scol = cc < 64 ? n0 + p : hh * HQ + 64 + (p & 1) * 16 + (p >> 1);
                tr_item((const float*)args.in[9], QC, 64 * kb, scol, Wqup, QL, n0, scr, FL.lane, (const float*)args.in[7]); continue; } r -= I_QUP;
            if (r < I_KVUP) { tr_plain64<true>((const float*)args.in[10], KVL, KVC, Wkvup, scr8, r, FL.lane, (const float*)args.in[8]); continue; } r -= I_KVUP;
            tr_plain64((const float*)args.in[11], DM, DM, Wob, scr8, r, FL.lane);
        }
        norm_pass(phase_frame(F), x, mix_g, HN);
        for (int i = F.bid * NWAVES * 64 + F.tid; i < T * 16; i += F.G * NWAVES * 64) { const int m = i >> 4, k = i & 15;
            float sk, ck; sincosf((float)positions[m] * powf(10000.0f, -(float)k / 16.0f), &sk, &ck); COS[i] = ck; SIN[i] = sk; }
    }
    GRID_BAR();
    if (PH(1)) { pg::StaticOrder S; S.init(T, QKVC, F.G, F.bid); pg::EpiQKV E{QKV, C2_DSA};
      pg::gemm_phase<pg::EpiQKV, pg::StaticOrder, false>(F.lds, HN, Wqkv, DM, DM, nullptr, S, E); }
    GRID_BAR();
    if (PH(2)) dilated_phase(phase_frame(F), QKV, positions, O3, LSE);
    GRID_BAR();
    if (PH(3)) merge_pass(phase_frame(F), O3, LSE, MIX);
    GRID_BAR();
    if (PH(4)) { pg::StaticOrder S; S.init(T, DM, F.G, F.bid); pg::EpiResBf<true, false> E{x, nullptr, XB1, SSQ};
      pg::gemm_phase<pg::EpiResBf<true, false>, pg::StaticOrder, false>(F.lds, MIX, Woa, DSAW, DSAW, nullptr, S, E); }
    GRID_BAR();
    if (PH(5)) { const Frame FL = phase_frame(F);
        for (int row = F.bid * NWAVES * 64 + F.tid; row < T; row += F.G * NWAVES * 64) RS[row] = pg::row_rrms(SSQ, row);
    }
    GRID_BAR();
    if (PH(6)) { pg::StaticOrder S; S.init(T, 2 * FF0, F.G, F.bid); pg::EpiSwiGLUT<1> E{ACT0, FF0, RS};
      pg::gemm_phase<pg::EpiSwiGLUT<1>, pg::StaticOrder, false>(F.lds, XB1, Wgu0, DM, DM, nullptr, S, E);
    }
    GRID_BAR();
    if (PH(7)) { pg::StaticOrder S; S.init(T, DM, F.G, F.bid); pg::EpiResBf<false, false> E{XB1, nullptr, XB2, SSQ};
      pg::gemm_phase<pg::EpiResBf<false, false>, pg::StaticOrder, false>(F.lds, ACT0, Wd0, FF0, FF0, nullptr, S, E); }
    GRID_BAR();
    if (PH(9)) { pg::StaticOrder S; S.init(T, MLA_INP, F.G, F.bid); pg::EpiLat E{CQ, CKV, KR, SSQ, SSL, COS, SIN};
      pg::gemm_phase<pg::EpiLat, pg::StaticOrder, false>(F.lds, XB2, Win, DM, DM, nullptr, S, E); }
    GRID_BAR();
    if (PH(11)) { pg::StaticOrder S; S.init(T, QC, F.G, F.bid); pg::EpiQRope E{Qb, COS, SIN, SSL};
      pg::gemm_phase<pg::EpiQRope, pg::StaticOrder, false>(F.lds, CQ, Wqup, QL, QL, nullptr, S, E); }
    if (PH(12)) { pg::StaticOrder S; S.init(T, KVC, F.G, F.bid); pg::EpiKVScale E{KVb, KVC, SSL};
      pg::gemm_phase<pg::EpiKVScale, pg::StaticOrder, false>(F.lds, CKV, Wkvup, KVL, KVL, nullptr, S, E); }
    GRID_BAR();
    if (PH(13)) mla_attn_phase4(phase_frame(F), Qb, KVb, KR, Ob);
    GRID_BAR();
    if (PH(14)) { pg::StaticOrder S; S.init(T, DM, F.G, F.bid); pg::EpiResBf<false, false> E{XB2, nullptr, HN, SSQ};
      pg::gemm_phase<pg::EpiResBf<false, false>, pg::StaticOrder, false>(F.lds, Ob, Wob, DM, DM, nullptr, S, E); }
    GRID_BAR();
    if (PH(15)) { router_pass(phase_frame(F), HN, ffn_g + DM, (const float*)args.in[15], RS, E01, GWT, CNT, LIST, RSROW, (unsigned*)HN8);
        __syncthreads();
        const Frame FL = phase_frame(F);
        constexpr int I_GU = 16 * 112, I_D = 56 * 16, I_E = I_GU + I_D;
        for (int it = gw; it < NEXP * I_E; it += NGW) {
            const int e = it / I_E; int r = it % I_E;
            if (r < I_GU) tr_gateup64<true, true>((const float*)args.in[16] + (size_t)e * DM * FFE, (const float*)args.in[17] + (size_t)e * DM * FFE, DM, FFE, Wmgu + (size_t)e * FFE * DM, scr8, r, FL.lane, ffn_g + DM);
            else tr_plain64<false, true>((const float*)args.in[18] + (size_t)e * FFE * DM, FFE, DM, Wmd + (size_t)e * DM * FFE / 2, scr8, r - I_GU, FL.lane);
        }
    }
    GRID_BAR();
    if (PH(16)) list_pass(phase_frame(F), E01, GWT, CNT, LIST, GWS, BASES, RS, RSROW, TFLAG, (2 * F.G / 4) * 256);
    GRID_BAR();
    {
        typedef pg::MoeOrder<2 * FFE / 256, 1, (long)FFE * DM> OrdGU;     typedef pg::MoeOrder<DM / 256, 1, (long)DM * FFE / 2> OrdDown; typedef pg::MoeOrder<DM / 256, MOE_TAIL_SPLIT, (long)DM * FFE / 2> OrdTail;
        const int nT0 = __builtin_amdgcn_readfirstlane(BASES[NEXP]) / 256, nT1 = __builtin_amdgcn_readfirstlane(BASES[9 + NEXP]) / 256, tmain = (2 * F.G) / 4;
#define MOE_BASES(S_, r_) do { _Pragma("unroll") for (int q_ = 0; q_ <= NEXP; ++q_) S_.base[q_] = __builtin_amdgcn_readfirstlane(BASES[(r_) * 9 + q_]); } while (0)
        const int tm0 = nT0 < tmain ? nT0 : tmain, tm1 = nT1 < tmain ? nT1 : tmain;
        const int off0 = ((((nT0 * (2 * FFE / 256)) % F.G) + 7) & ~7) % F.G;
        const int nq0 = (nT0 > tmain ? nT0 - tmain : 0) * (DM / 256) * MOE_TAIL_SPLIT;
        const int nq1 = (nT1 > tmain ? nT1 - tmain : 0) * (DM / 256) * MOE_TAIL_SPLIT;
        bf16_t* T1p = (bf16_t*)((ws + 1 * MiB) - (size_t)tmain * 256 * FFE);
#pragma unroll 1
        for (int k = 0; k < 3; ++k) {
            if (k == 2) {
                GRID_BAR();
                for (int rk = 0; rk < 2; ++rk)
                    for (int r = tmain * 256 + gw; r < (rk == 0 ? nT0 : nT1) * 256; r += NGW) { const int tok = LIST[rk * MOE_MAXROWS + r];
                        if (tok >= 0) { f32x4* orow = (f32x4*)(out + (size_t)tok * DM) + F.lane;
#pragma unroll
                            for (int j = 0; j < 4; ++j) orow[64 * j] = (f32x4){0.f, 0.f, 0.f, 0.f}; } }
                { OrdDown S; S.G = F.G; S.c = F.bid; MOE_BASES(S, 0);
                  S.t0 = 0; S.t1 = tm0; S.klen = 0;
                  pg::EpiMoeDown E{HN, LIST, GWS};
                  pg::gemm_phase<pg::EpiMoeDown, OrdDown, false, true, 0, 0>(F.lds, ACTE, Wmd, FFE / 2, FFE / 2, nullptr, S, E); }
                GRID_BAR();
#pragma unroll 1
                for (int r = 0; r < 2; ++r) {
                    OrdTail S; S.G = F.G; S.c = r == 0 ? F.bid : (F.bid - (nq0 % F.G) + F.G) % F.G; MOE_BASES(S, r);
                    S.t0 = tmain; S.t1 = r == 0 ? nT0 : nT1; S.klen = FFE / 2 / MOE_TAIL_SPLIT;
                    pg::EpiMoeDownAtomic E{out, LIST + r * MOE_MAXROWS, GWS + r * MOE_MAXROWS};
                    pg::gemm_phase<pg::EpiMoeDownAtomic, OrdTail, false, true, 0, 0>(F.lds, r == 0 ? ACTE : T1p, Wmd, FFE / 2 / MOE_TAIL_SPLIT, FFE / 2, nullptr, S, E);
                }
            }
            OrdGU S; S.G = F.G; S.c = k == 1 ? (F.bid - off0 + F.G) % F.G : F.bid; MOE_BASES(S, k == 0 ? 0 : 1);
            S.t0 = k == 1 ? tmain : 0; S.t1 = k == 0 ? nT0 : (k == 1 ? nT1 : tm1); S.klen = 0;
            if (k == 2) { const int nwg = tm1 * (2 * FFE / 256), ntc = nq0 + nq1;
                int Gm = F.G; asm volatile("" : "+s"(Gm));
                if (nwg % Gm == 0 && nwg >= 2 * Gm && ntc > 0 && 2 * ntc <= Gm) { S.rd_ntc = ntc; S.rd_R = nwg / Gm - 2; } }
            pg::EpiSwiGLU E{k == 1 ? T1p : ACTE, FFE, RSROW + (k == 0 ? 0 : MOE_MAXROWS)};
            pg::gemm_phase<pg::EpiSwiGLU, OrdGU, true, true, 0, 0>(F.lds, HN8, Wmgu, DM / 2, DM / 2, LIST + (k == 0 ? 0 : MOE_MAXROWS), S, E);
        }
        GRID_BAR();
        { OrdDown S; S.G = F.G; S.c = F.bid; MOE_BASES(S, 1);
          S.t0 = 0; S.t1 = tm1; S.klen = 0;
          pg::EpiMoeDown E{HN, LIST + MOE_MAXROWS, GWS + MOE_MAXROWS};
          pg::gemm_phase<pg::EpiMoeDown, OrdDown, false, true, 0, 0>(F.lds, ACTE, Wmd, FFE / 2, FFE / 2, nullptr, S, E); }
        GRID_BAR();
#undef MOE_BASES
    }
    if (PH(19)) { const Frame FL = phase_frame(F);
        f32x4 gv[4]; load_gain((const float*)args.in[19], gv, FL.lane);
        u32x2 vb[4], vnb[4]; int tf = 0, tfn = 0;
        if (gw < T) { const u32x2* xr = (const u32x2*)(HN + (size_t)gw * DM) + FL.lane; tf = TFLAG[gw];
#pragma unroll
            for (int j = 0; j < 4; ++j) vb[j] = xr[64 * j]; }
        for (int m = gw; m < T; m += NGW) {
            const int mn = m + NGW < T ? m + NGW : m;
            { const u32x2* xr = (const u32x2*)(HN + (size_t)mn * DM) + FL.lane; tfn = TFLAG[mn];
#pragma unroll
              for (int j = 0; j < 4; ++j) vnb[j] = xr[64 * j]; }
            __builtin_amdgcn_sched_barrier(0);
            f32x4 v[4];
#pragma unroll
            for (int j = 0; j < 4; ++j) v[j] = (f32x4){bflo(vb[j].x), bfhi(vb[j].x), bflo(vb[j].y), bfhi(vb[j].y)};
            f32x4* xw = (f32x4*)(out + (size_t)m * DM) + FL.lane;
            if (__builtin_amdgcn_readfirstlane(tf)) {
#pragma unroll
                for (int j = 0; j < 4; ++j) v[j] = v[j] + xw[64 * j]; }
            float s = 0.f;
#pragma unroll
            for (int j = 0; j < 4; ++j) s += (v[j].x * v[j].x + v[j].y * v[j].y) + (v[j].z * v[j].z + v[j].w * v[j].w);
            const float r = __builtin_amdgcn_rsqf(wave_sum(s) * (1.f / DM) + RMS_EPS);
#pragma unroll
            for (int j = 0; j < 4; ++j) xw[64 * j] = v[j] * r * gv[j];
#pragma unroll
            for (int j = 0; j < 4; ++j) vb[j] = vnb[j];
            tf = tfn;
        }
    }
}

extern "C" void kernel_launch(void* const* d_in, const int* in_sizes, int n_in, void* d_out, int out_size, void* d_ws, size_t ws_size, hipStream_t stream) {
    static int grid = 0;
    if (grid == 0) {
        if (n_in != 20 || in_sizes[0] != T * DM || out_size != T * DM || ws_size < WS_END) { fprintf(stderr, "kernel_launch: unexpected shapes / workspace (%d inputs, ws %zu < %zu)\n", n_in, ws_size, (size_t)WS_END); grid = -1; return; }
        int dev = 0, cus = 0, per_cu = 0;
        if (hipGetDevice(&dev) != hipSuccess || hipDeviceGetAttribute(&cus, hipDeviceAttributeMultiprocessorCount, dev) != hipSuccess) { grid = -1; return; }
        if (hipFuncSetAttribute((const void*)trunk_fwd, hipFuncAttributeMaxDynamicSharedMemorySize, LDS_BYTES) != hipSuccess) { fprintf(stderr, "kernel_launch: hipFuncSetAttribute failed\n"); grid = -1; return; }
        if (hipOccupancyMaxActiveBlocksPerMultiprocessor(&per_cu, (const void*)trunk_fwd, NWAVES * 64, LDS_BYTES) != hipSuccess || per_cu < 1) { fprintf(stderr, "kernel_launch: occupancy query says %d\n", per_cu); }
        (void)hipGetLastError();
        grid = cus;
    }
    if (grid < 0) return;
    (void)hipMemsetAsync((char*)d_ws + WS_CTL, 0, CTL_ZERO_BYTES, stream);
    Args a{};
    for (int i = 0; i < 20; ++i) a.in[i] = d_in[i];
    a.out = (float*)d_out; a.ws = (unsigned char*)d_ws;
    hipLaunchKernelGGL(trunk_fwd, dim3(grid), dim3(NWAVES * 64), LDS_BYTES, stream, a);
}
```
